# Optimizing an MI355X kernel written in HIP

```python
import jax, jax.numpy as jnp
from jax import lax
import numpy as np

D_MODEL = 1024
BATCH = 32
SEQ = 256
DEPTH = 2
DEC_BATCH = 8
DEC_SEQ = 1024
PAST_LEN = 512

GRID_W = 64
HEAD_DIM = 64
BRANCH_W = 512
A_HEADS = BRANCH_W // HEAD_DIM
A_KV_HEADS = 2
A_KV_W = A_KV_HEADS * HEAD_DIM
A_WINDOW = 128
A_BLOCK = 128
B_HEADS = BRANCH_W // HEAD_DIM
NB_ROWS = 8
NB_COLS = 16
NB_QCOLS = 16
NB_KCOLS = 32
LRU_WIDTH = BRANCH_W
LRU_BLOCKS = 8
LRU_BW = LRU_WIDTH // LRU_BLOCKS
LRU_C = 8.0
CONV_W = 4
N_BRANCH = 3
Q_BLOCK = 128
ROPE_BASE = 10000.0
EPS = 1e-6
NEG_INF = -1e30
IN_SPLITS = (BRANCH_W, A_KV_W, A_KV_W, BRANCH_W,
             BRANCH_W, BRANCH_W, BRANCH_W, BRANCH_W,
             LRU_WIDTH, LRU_WIDTH,
             D_MODEL, D_MODEL, D_MODEL)
IN_COLS = sum(IN_SPLITS)
IN_OFFSETS = tuple(int(v) for v in np.cumsum(IN_SPLITS)[:-1])

kernel_name = "hybrid_diffusion_prefix_trunk_step"


def rms_norm(x, g):
    x32 = x.astype(jnp.float32)
    y = x32 * lax.rsqrt(jnp.mean(x32 * x32, axis=-1, keepdims=True) + EPS)
    return (y * g.astype(jnp.float32)).astype(x.dtype)


def mixer_inputs(x, cond, norm_g, w_ada, b_ada, w_in):
    mod = jax.nn.silu(cond) @ w_ada + b_ada
    if mod.ndim == 2:
        mod = mod[:, None, :]
    shift, scale, gate = jnp.split(mod, 3, axis=-1)
    h = rms_norm(x, norm_g) * (1 + scale) + shift
    return jnp.split(h @ w_in, IN_OFFSETS, axis=-1), gate


def rope_axis(x, pos):
    m = x.shape[-1] // 2
    freqs = ROPE_BASE ** (-jnp.arange(m, dtype=jnp.float32) / m)
    ang = pos.astype(jnp.float32)[:, None] * freqs[None, :]
    cos = jnp.cos(ang)[None, :, None, :].astype(x.dtype)
    sin = jnp.sin(ang)[None, :, None, :].astype(x.dtype)
    x1, x2 = x[..., :m], x[..., m:]
    return jnp.concatenate([x1 * cos - x2 * sin, x2 * cos + x1 * sin], axis=-1)


def rope_2d(x):
    t = jnp.arange(x.shape[1])
    half = x.shape[-1] // 2
    return jnp.concatenate([rope_axis(x[..., :half], t // GRID_W),
                            rope_axis(x[..., half:], t % GRID_W)], axis=-1)


def context_attention(q, k, v, sink):
    bsz, s_len, hq, dh = q.shape
    hkv = k.shape[2]
    g = hq // hkv
    nb = s_len // Q_BLOCK
    scale = dh ** -0.5
    qb = jnp.moveaxis(q.reshape(bsz, nb, Q_BLOCK, hkv, g, dh), 1, 0)

    def block(qi):
        s = jnp.einsum('bqhgd,bkhd->bhgqk', qi, k).astype(jnp.float32) * scale
        if sink is not None:
            sk = jnp.broadcast_to(sink.astype(jnp.float32).reshape(1, hkv, g, 1, 1), s.shape[:-1] + (1,))
            s = jnp.concatenate([s, sk], axis=-1)
        p = jax.nn.softmax(s, axis=-1)[..., :s_len].astype(v.dtype)
        return jnp.einsum('bhgqk,bkhd->bqhgd', p, v)

    o = lax.map(block, qb)
    return jnp.moveaxis(o, 0, 1).reshape(bsz, s_len, hq * dh)


def window_attention(q, k, v, kc, vc, sink):
    bsz, t_len, hq, dh = q.shape
    hkv = k.shape[2]
    g = hq // hkv
    nb = t_len // A_BLOCK
    nloc = 3 * A_BLOCK
    scale = dh ** -0.5
    qb = jnp.moveaxis(q.reshape(bsz, nb, A_BLOCK, hkv, g, dh), 1, 0)

    def band(x):
        xp = jnp.pad(x.reshape(bsz, nb, A_BLOCK, hkv, dh), ((0, 0), (1, 1), (0, 0), (0, 0), (0, 0)))
        xb = jnp.concatenate([xp[:, :-2], xp[:, 1:-1], xp[:, 2:]], axis=2)
        return jnp.moveaxis(xb, 1, 0)

    kb, vb = band(k), band(v)
    blk = jnp.arange(nb)[:, None, None]
    qpos = blk * A_BLOCK + jnp.arange(A_BLOCK)[None, :, None]
    kpos = (blk - 1) * A_BLOCK + jnp.arange(nloc)[None, None, :]
    valid = (jnp.abs(qpos - kpos) <= A_WINDOW) & (kpos >= 0) & (kpos < t_len)
    sk = sink.astype(jnp.float32).reshape(1, hkv, g, 1, 1)

    def block(args):
        qi, ki, vi, mi = args
        s_loc = jnp.einsum('bqhgd,bkhd->bhgqk', qi, ki).astype(jnp.float32) * scale
        s_loc = jnp.where(mi, s_loc, NEG_INF)
        s_ctx = jnp.einsum('bqhgd,bphd->bhgqp', qi, kc).astype(jnp.float32) * scale
        s_snk = jnp.broadcast_to(sk, s_loc.shape[:-1] + (1,))
        p = jax.nn.softmax(jnp.concatenate([s_loc, s_ctx, s_snk], axis=-1), axis=-1).astype(v.dtype)
        return (jnp.einsum('bhgqk,bkhd->bqhgd', p[..., :nloc], vi)
                + jnp.einsum('bhgqp,bphd->bqhgd', p[..., nloc:-1], vc))

    o = lax.map(block, (qb, kb, vb, valid))
    return jnp.moveaxis(o, 0, 1).reshape(bsz, t_len, hq * dh)


def neighbourhood_attention(q, k, v, kc, vc, rpb):
    bsz, t_len, h, dh = q.shape
    rows = t_len // GRID_W
    kh = min(NB_ROWS, rows)
    ncb = GRID_W // NB_QCOLS
    nkeys = kh * NB_KCOLS
    scale = dh ** -0.5
    row_start = jnp.clip(jnp.arange(rows) - kh // 2, 0, rows - kh)
    kcol0 = jnp.clip(jnp.arange(ncb) * NB_QCOLS - (NB_KCOLS - NB_QCOLS) // 2, 0, GRID_W - NB_KCOLS)
    kcol = kcol0[:, None] + jnp.arange(NB_KCOLS)[None, :]
    qcol = jnp.arange(ncb)[:, None] * NB_QCOLS + jnp.arange(NB_QCOLS)[None, :]
    cs = jnp.clip(qcol - NB_COLS // 2, 0, GRID_W - NB_COLS)
    col_ok = (kcol[:, None, :] >= cs[:, :, None]) & (kcol[:, None, :] < cs[:, :, None] + NB_COLS)
    mask = jnp.broadcast_to(col_ok[:, :, None, :], (ncb, NB_QCOLS, kh, NB_KCOLS)).reshape(ncb, NB_QCOLS, nkeys)
    dc_idx = jnp.clip(kcol[:, None, :] - qcol[:, :, None] + NB_COLS - 1, 0, 2 * NB_COLS - 2)
    qr = jnp.moveaxis(q.reshape(bsz, rows, ncb, NB_QCOLS, h, dh), 1, 0)

    def block(args):
        qi, r = args
        krow = row_start[r] + jnp.arange(kh)
        idx = (krow[None, :, None] * GRID_W + kcol[:, None, :]).reshape(-1)
        ki = jnp.take(k, idx, axis=1).reshape(bsz, ncb, nkeys, h, dh)
        vi = jnp.take(v, idx, axis=1).reshape(bsz, ncb, nkeys, h, dh)
        dr_idx = krow - r + NB_ROWS - 1
        bias = rpb[:, dr_idx[None, None, :, None], dc_idx[:, :, None, :]]
        bias = jnp.moveaxis(bias.reshape(h, ncb, NB_QCOLS, nkeys), 0, 1)
        s_loc = jnp.einsum('bjqhd,bjkhd->bjhqk', qi, ki).astype(jnp.float32) * scale + bias.astype(jnp.float32)
        s_loc = jnp.where(mask[:, None], s_loc, NEG_INF)
        s_ctx = jnp.einsum('bjqhd,bphd->bjhqp', qi, kc).astype(jnp.float32) * scale
        p = jax.nn.softmax(jnp.concatenate([s_loc, s_ctx], axis=-1), axis=-1).astype(v.dtype)
        o = (jnp.einsum('bjhqk,bjkhd->bjqhd', p[..., :nkeys], vi)
             + jnp.einsum('bjhqp,bphd->bjqhd', p[..., nkeys:], vc))
        return o.reshape(bsz, GRID_W, h * dh)

    o = lax.map(block, (qr, jnp.arange(rows)))
    return jnp.moveaxis(o, 0, 1).reshape(bsz, t_len, h * dh)


def depthwise_conv(x, w, b):
    t_len = x.shape[1]
    lo = CONV_W // 2
    xp = jnp.pad(x, ((0, 0), (lo, CONV_W - 1 - lo), (0, 0)))
    y = b
    for j in range(CONV_W):
        y = y + xp[:, j:j + t_len] * w[j]
    return y


def rglru_coeffs(xc, wa, ba, wx, bx, lam):
    bsz, t_len, _ = xc.shape
    xb = xc.reshape(bsz, t_len, LRU_BLOCKS, LRU_BW)
    r = jax.nn.sigmoid((jnp.einsum('btnk,dnkj->dbtnj', xb, wa).reshape(2, bsz, t_len, LRU_WIDTH)
                        + ba[:, None, None, :]).astype(jnp.float32))
    i = jax.nn.sigmoid((jnp.einsum('btnk,dnkj->dbtnj', xb, wx).reshape(2, bsz, t_len, LRU_WIDTH)
                        + bx[:, None, None, :]).astype(jnp.float32))
    log_a = -LRU_C * jax.nn.softplus(-lam.astype(jnp.float32))[:, None, None, :] * r
    a = jnp.exp(log_a)
    u = jnp.sqrt(-jnp.expm1(2.0 * log_a)) * i * xc.astype(jnp.float32)[None]
    return a, u


def _combine(left, right):
    a1, b1 = left
    a2, b2 = right
    return a1 * a2, a2 * b1 + b2


def linear_scan(a, u, h0, reverse):
    acum, ucum = lax.associative_scan(_combine, (a, u), axis=1, reverse=reverse)
    return acum * h0[:, None, :] + ucum


def merge_branches(ya, yb, yc, ga, gb, gc, w_br, w_out):
    z = (jax.nn.sigmoid(ga) * (ya @ w_br[0]) + jax.nn.sigmoid(gb) * (yb @ w_br[1])
         + jax.nn.sigmoid(gc) * (yc @ w_br[2]))
    return z @ w_out


def context_layer(x, c_ctx, norm_g, w_ada, b_ada, w_in, a_qn, a_kn, a_sink, b_qn, b_kn,
                  conv_w, conv_b, wa, ba, wx, bx, lam, w_br, w_out):
    (aq, ak, av, ag, bq, bk, bv, bg, cx, cg, ga, gb, gc), gate = mixer_inputs(x, c_ctx, norm_g, w_ada, b_ada, w_in)
    bsz, s_len, _ = x.shape
    qa = rms_norm(aq.reshape(bsz, s_len, A_HEADS, HEAD_DIM), a_qn)
    ka = rms_norm(ak.reshape(bsz, s_len, A_KV_HEADS, HEAD_DIM), a_kn)
    va = av.reshape(bsz, s_len, A_KV_HEADS, HEAD_DIM)
    ya = context_attention(qa, ka, va, a_sink) * jax.nn.silu(ag)
    qb = rms_norm(bq.reshape(bsz, s_len, B_HEADS, HEAD_DIM), b_qn)
    kb = rms_norm(bk.reshape(bsz, s_len, B_HEADS, HEAD_DIM), b_kn)
    vb = bv.reshape(bsz, s_len, B_HEADS, HEAD_DIM)
    yb = context_attention(qb, kb, vb, None) * jax.nn.silu(bg)
    xc = depthwise_conv(cx, conv_w, conv_b)
    a, u = rglru_coeffs(xc, wa, ba, wx, bx, lam)
    h0 = jnp.zeros((bsz, LRU_WIDTH), jnp.float32)
    hf = linear_scan(a[0], u[0], h0, False)
    hb = linear_scan(a[1], u[1], h0, True)
    yc = (hf + hb).astype(x.dtype) * jax.nn.silu(cg)
    lru_state = jnp.stack([hf[:, -1], hb[:, 0]], axis=1)
    out = merge_branches(ya, yb, yc, ga, gb, gc, w_br, w_out)
    return x + gate * out, ka, va, kb, vb, lru_state


def latent_layer(x, c, ka_c, va_c, kb_c, vb_c, st, norm_g, w_ada, b_ada, w_in, a_qn, a_kn, a_sink,
                 b_qn, b_kn, b_rpb, conv_w, conv_b, wa, ba, wx, bx, lam, w_br, w_out):
    (aq, ak, av, ag, bq, bk, bv, bg, cx, cg, ga, gb, gc), gate = mixer_inputs(x, c, norm_g, w_ada, b_ada, w_in)
    bsz, t_len, _ = x.shape
    qa = rope_2d(rms_norm(aq.reshape(bsz, t_len, A_HEADS, HEAD_DIM), a_qn))
    ka = rope_2d(rms_norm(ak.reshape(bsz, t_len, A_KV_HEADS, HEAD_DIM), a_kn))
    va = av.reshape(bsz, t_len, A_KV_HEADS, HEAD_DIM)
    ya = window_attention(qa, ka, va, ka_c, va_c, a_sink) * jax.nn.silu(ag)
    qb = rms_norm(bq.reshape(bsz, t_len, B_HEADS, HEAD_DIM), b_qn)
    kb = rms_norm(bk.reshape(bsz, t_len, B_HEADS, HEAD_DIM), b_kn)
    vb = bv.reshape(bsz, t_len, B_HEADS, HEAD_DIM)
    yb = neighbourhood_attention(qb, kb, vb, kb_c, vb_c, b_rpb) * jax.nn.silu(bg)
    xc = depthwise_conv(cx, conv_w, conv_b)
    a, u = rglru_coeffs(xc, wa, ba, wx, bx, lam)
    st32 = st.astype(jnp.float32)
    hf = linear_scan(a[0], u[0], st32[:, 0], False)
    hb = linear_scan(a[1], u[1], st32[:, 1], True)
    yc = (hf + hb).astype(x.dtype) * jax.nn.silu(cg)
    out = merge_branches(ya, yb, yc, ga, gb, gc, w_br, w_out)
    return x + gate * out


def setup_inputs(seed: int = 0) -> dict:
    key = jax.random.key(seed)
    ks = jax.random.split(key, 32)
    f32 = jnp.float32
    nrm = lambda k, shape, s: jax.random.normal(k, shape, f32) * s
    lam_u = jax.random.uniform(ks[24], (DEPTH, 2, LRU_WIDTH), f32, minval=0.9, maxval=0.999)
    return {
        "x_prompt": nrm(ks[0], (BATCH, SEQ, D_MODEL), 1.0),
        "x_sample": nrm(ks[1], (DEC_BATCH, DEC_SEQ, D_MODEL), 1.0),
        "cache_ka": nrm(ks[2], (DEC_BATCH, DEPTH, PAST_LEN, A_KV_HEADS, HEAD_DIM), 1.0),
        "cache_va": nrm(ks[3], (DEC_BATCH, DEPTH, PAST_LEN, A_KV_HEADS, HEAD_DIM), 1.0),
        "cache_kb": nrm(ks[4], (DEC_BATCH, DEPTH, PAST_LEN, B_HEADS, HEAD_DIM), 1.0),
        "cache_vb": nrm(ks[5], (DEC_BATCH, DEPTH, PAST_LEN, B_HEADS, HEAD_DIM), 1.0),
        "state_lru": nrm(ks[6], (DEC_BATCH, DEPTH, 2, LRU_WIDTH), 0.5),
        "c": nrm(ks[7], (DEC_BATCH, D_MODEL), 1.0),
        "c_ctx": nrm(ks[8], (D_MODEL,), 1.0),
        "norm_g": 1.0 + nrm(ks[9], (DEPTH, D_MODEL), 0.02),
        "w_ada": nrm(ks[10], (DEPTH, D_MODEL, 3 * D_MODEL), D_MODEL ** -0.5),
        "b_ada": nrm(ks[11], (DEPTH, 3 * D_MODEL), 0.02),
        "w_in": nrm(ks[12], (DEPTH, D_MODEL, IN_COLS), D_MODEL ** -0.5),
        "a_q_norm": 1.0 + nrm(ks[13], (DEPTH, HEAD_DIM), 0.02),
        "a_k_norm": 1.0 + nrm(ks[14], (DEPTH, HEAD_DIM), 0.02),
        "a_sink": nrm(ks[15], (DEPTH, A_HEADS), 0.5),
        "b_q_norm": 1.0 + nrm(ks[16], (DEPTH, HEAD_DIM), 0.02),
        "b_k_norm": 1.0 + nrm(ks[17], (DEPTH, HEAD_DIM), 0.02),
        "b_rpb": nrm(ks[18], (DEPTH, B_HEADS, 2 * NB_ROWS - 1, 2 * NB_COLS - 1), 0.1),
        "lru_conv_w": nrm(ks[19], (DEPTH, CONV_W, LRU_WIDTH), CONV_W ** -0.5),
        "lru_conv_b": nrm(ks[20], (DEPTH, LRU_WIDTH), 0.02),
        "lru_wa": nrm(ks[21], (DEPTH, 2, LRU_BLOCKS, LRU_BW, LRU_BW), LRU_BW ** -0.5),
        "lru_ba": nrm(ks[22], (DEPTH, 2, LRU_WIDTH), 0.02),
        "lru_wx": nrm(ks[23], (DEPTH, 2, LRU_BLOCKS, LRU_BW, LRU_BW), LRU_BW ** -0.5),
        "lru_bx": nrm(ks[25], (DEPTH, 2, LRU_WIDTH), 0.02),
        "lru_lambda": jnp.log(lam_u) - jnp.log1p(-lam_u),
        "w_branch": nrm(ks[26], (DEPTH, N_BRANCH, BRANCH_W, D_MODEL), BRANCH_W ** -0.5),
        "w_out": nrm(ks[27], (DEPTH, D_MODEL, D_MODEL), D_MODEL ** -0.5),
    }


def reference(x_prompt, x_sample, cache_ka, cache_va, cache_kb, cache_vb, state_lru, c, c_ctx,
              norm_g, w_ada, b_ada, w_in, a_q_norm, a_k_norm, a_sink, b_q_norm, b_k_norm, b_rpb,
              lru_conv_w, lru_conv_b, lru_wa, lru_ba, lru_wx, lru_bx, lru_lambda, w_branch, w_out):
    y_prompt = x_prompt
    y_sample = x_sample
    new_ka, new_va, new_kb, new_vb, new_lru = [], [], [], [], []
    for l in range(DEPTH):
        y_prompt, ka, va, kb, vb, st = context_layer(
            y_prompt, c_ctx, norm_g[l], w_ada[l], b_ada[l], w_in[l], a_q_norm[l], a_k_norm[l], a_sink[l],
            b_q_norm[l], b_k_norm[l], lru_conv_w[l], lru_conv_b[l], lru_wa[l], lru_ba[l], lru_wx[l],
            lru_bx[l], lru_lambda[l], w_branch[l], w_out[l])
        new_ka.append(ka)
        new_va.append(va)
        new_kb.append(kb)
        new_vb.append(vb)
        new_lru.append(st)
        y_sample = latent_layer(
            y_sample, c, cache_ka[:, l], cache_va[:, l], cache_kb[:, l], cache_vb[:, l], state_lru[:, l],
            norm_g[l], w_ada[l], b_ada[l], w_in[l], a_q_norm[l], a_k_norm[l], a_sink[l],
            b_q_norm[l], b_k_norm[l], b_rpb[l], lru_conv_w[l], lru_conv_b[l], lru_wa[l], lru_ba[l],
            lru_wx[l], lru_bx[l], lru_lambda[l], w_branch[l], w_out[l])
    new_cache_ka = jnp.stack(new_ka, axis=1)
    new_cache_va = jnp.stack(new_va, axis=1)
    new_cache_kb = jnp.stack(new_kb, axis=1)
    new_cache_vb = jnp.stack(new_vb, axis=1)
    new_state_lru = jnp.stack(new_lru, axis=1)
    return (y_prompt, y_sample, new_cache_ka, new_cache_va, new_cache_kb, new_cache_vb, new_state_lru)
```

```cpp
#include <hip/hip_runtime.h>
#include <hip/hip_cooperative_groups.h>
#include <cstdio>
namespace cg = cooperative_groups;

#define ATTN_SIMPLE 1
#ifndef ONE_LAUNCH
#define ONE_LAUNCH 1
#endif

typedef unsigned short bf16_t;
typedef short bf16x8 __attribute__((ext_vector_type(8)));
typedef short bf16x4 __attribute__((ext_vector_type(4)));
typedef float f32x4 __attribute__((ext_vector_type(4)));
#define DEV __device__ __forceinline__
#define LAS __attribute__((address_space(3)))

constexpr int DM = 1024, NCOL = 7424, NTOK = 8192;
constexpr float LOG2E = 1.4426950408889634f;
constexpr size_t O_Y = 0, O_KA = 16777216, O_VA = 18874368, O_KB = 20971520, O_VB = 29360128, O_LRU = 37748736;
constexpr int C_AQ = 0, C_AK = 512, C_AG = 768, C_BQ = 1280, C_BK = 1792, C_BG = 2816, C_CX = 3328, C_CG = 3840, C_MG = 4352;
constexpr size_t W_WT_IN = 0;
constexpr size_t W_WT_BR = W_WT_IN + (size_t)2 * NCOL * 1024 * 2;
constexpr size_t W_WT_OUT = W_WT_BR + (size_t)6 * 1024 * 512 * 2;
constexpr size_t W_WG = W_WT_OUT + (size_t)2 * 1024 * 1024 * 2;
constexpr size_t W_CKA = W_WG + (size_t)32 * 128 * 64 * 2;
constexpr size_t W_CVAT = W_CKA + (size_t)16 * 512 * 128 * 2;
constexpr size_t W_CKB = W_CVAT + (size_t)16 * 128 * 512 * 2;
constexpr size_t W_CVBT = W_CKB + (size_t)16 * 512 * 512 * 2;
constexpr int KS_ADA = 16;
constexpr size_t W_MODP = W_CVBT + (size_t)16 * 512 * 512 * 2;
constexpr size_t W_MOD = W_MODP + (size_t)KS_ADA * 2 * 9 * 3072 * 4;
constexpr size_t W_ROPE = W_MOD + (size_t)2 * 9 * 3072 * 4;
constexpr size_t W_CTR = W_ROPE + 8192;
constexpr size_t W_H = W_CTR + 8192;
constexpr size_t W_P = W_H + (size_t)NTOK * 1024 * 2;
constexpr size_t W_VAT = W_P + (size_t)NTOK * NCOL * 2;
constexpr size_t W_VBT = W_VAT + (size_t)NTOK * 128 * 2;
constexpr size_t W_HF = W_VBT + (size_t)NTOK * 512 * 2;
constexpr size_t W_HB = W_HF + (size_t)NTOK * 512 * 4;
constexpr size_t W_Y = W_HB + (size_t)NTOK * 512 * 4;
constexpr size_t W_BAR = W_Y + (size_t)NTOK * 1024 * 2;
constexpr size_t W_END = W_BAR + 16384;
static_assert(W_END <= (size_t)256 * 1024 * 1024, "workspace too large");

constexpr int GA_BYTES = 256 * 64 * 2, GB_BYTES = 128 * 64 * 2, GSTAGE = GA_BYTES + GB_BYTES;
constexpr int LDS_GEMM = 3 * GSTAGE;
constexpr int LDS_BYTES = LDS_GEMM + 16;
constexpr int EP_LD = 132;
constexpr int NPHASE = 26;

struct Params {
  const float* in[28];
  float* out;
  unsigned char* ws;
};
struct PV {
  const Params* pp; long zs; unsigned char* ws; float* out;
  DEV const float* IN(int i) const { return (const float*)((const char*)pp->in[i] + zs); }
  DEV float* OUT() const { return out; }
  DEV unsigned char* WS() const { return ws; }
};

DEV int ltid() { int t = threadIdx.x; asm volatile("" : "+v"(t)); return t; }
DEV float bf2f(unsigned short b) { return __uint_as_float(((unsigned)b) << 16); }
typedef __bf16 bf16v2_t __attribute__((ext_vector_type(2)));
typedef float f32v2_t __attribute__((ext_vector_type(2)));
DEV unsigned pk_bf16(float lo, float hi) { f32v2_t f = {lo, hi}; bf16v2_t b = __builtin_convertvector(f, bf16v2_t); return __builtin_bit_cast(unsigned, b); }
DEV float ex2(float x) { return __builtin_amdgcn_exp2f(x); }
DEV float sigm(float x) { return __builtin_amdgcn_rcpf(1.f + ex2(-x * LOG2E)); }
DEV f32x4 mfma16(bf16x8 a, bf16x8 b, f32x4 c) { return __builtin_amdgcn_mfma_f32_16x16x32_bf16(a, b, c, 0, 0, 0); }
DEV void quad_gather(float x, float (&q)[4]) {
  const unsigned xi = __float_as_uint(x);
  const auto r = __builtin_amdgcn_permlane16_swap(xi, xi, false, false);
  const auto e = __builtin_amdgcn_permlane32_swap(r[0], r[0], false, false);
  const auto o = __builtin_amdgcn_permlane32_swap(r[1], r[1], false, false);
  q[0] = __uint_as_float(e[0]); q[1] = __uint_as_float(o[0]); q[2] = __uint_as_float(e[1]); q[3] = __uint_as_float(o[1]);
}
DEV float quad_max(float x) { float q[4]; quad_gather(x, q); return fmaxf(fmaxf(q[0], q[1]), fmaxf(q[2], q[3])); }
DEV void store_bf16x4(bf16_t* p, float a, float b, float c, float d) { uint2 v; v.x = pk_bf16(a, b); v.y = pk_bf16(c, d); *(uint2*)p = v; }


#define XB_TMO      128
#define XB_XCNT(j)  (256  + 64 * (j))
#define XB_XSUB(j)  (1280 + 64 * (j))
#define XB_XGEN(j)  (2304 + 64 * (j))
#define XB_TOP      3328
#define XB_TOPGEN   3392
#define XCD_BAR_WORDS 3456
#define XB_SPIN_CAP (1u << 18)
DEV unsigned xb_ld(unsigned* p) { return __hip_atomic_load(p, __ATOMIC_RELAXED, __HIP_MEMORY_SCOPE_AGENT); }
DEV unsigned xb_add(unsigned* p, unsigned v) { return __hip_atomic_fetch_add(p, v, __ATOMIC_RELAXED, __HIP_MEMORY_SCOPE_AGENT); }
DEV unsigned xb_xcc_id() { return (unsigned)__builtin_amdgcn_s_getreg((3 << 11) | 20) & 0xFu; }
#define XB_SPIN(cond, bar) do { unsigned _sp = 0; while (cond) { __builtin_amdgcn_s_sleep(1); \
    if ((++_sp & 255u) == 0u) { if (xb_ld(&(bar)[XB_TMO])) break; if (_sp > XB_SPIN_CAP) { atomicAdd(&(bar)[XB_TMO], 1u); break; } } } } while (0)
struct XcdBarrier { unsigned* bar; unsigned x; volatile LAS unsigned* st; };
DEV XcdBarrier xcd_barrier_post(unsigned* bar, volatile LAS unsigned* st) {
  XcdBarrier b; b.bar = bar; b.x = xb_xcc_id(); b.st = st;
  if (threadIdx.x == 0) (void)xb_add(&bar[XB_XCNT(b.x)], 1u);
  return b;
}
DEV void xcd_barrier_complete(unsigned* bar, unsigned x, unsigned& nloc, unsigned& nx) {
  const unsigned G = gridDim.x * gridDim.y * gridDim.z;
  unsigned sum, cnt, mine, sp = 0u;
  for (;;) {
    sum = 0u; cnt = 0u; mine = 0u;
#pragma unroll
    for (unsigned j = 0; j < 16; ++j) { const unsigned c = xb_ld(&bar[XB_XCNT(j)]); sum += c; cnt += (c > 0u) ? 1u : 0u; mine = (j == x) ? c : mine; }
    if (sum == G) break;
    __builtin_amdgcn_s_sleep(1);
    if ((++sp & 255u) == 0u) { if (xb_ld(&bar[XB_TMO])) break; if (sp > XB_SPIN_CAP) { atomicAdd(&bar[XB_TMO], 1u); break; } }
  }
  nloc = mine > 0u ? mine : 1u; nx = cnt > 0u ? cnt : 1u;
}
DEV void xcd_barrier(const XcdBarrier& b) {
  asm volatile("s_waitcnt vmcnt(0)" ::: "memory");
  __syncthreads();
  if (threadIdx.x == 0) {
    unsigned* bar = b.bar;
    asm volatile("" : "+s"(bar));
    __builtin_amdgcn_s_waitcnt(0);
    unsigned nloc = b.st[0], nx = b.st[1];
    if (nloc == 0u) { xcd_barrier_complete(bar, b.x, nloc, nx); b.st[0] = nloc; b.st[1] = nx; }
    const unsigned old = xb_add(&bar[XB_XSUB(b.x)], 1u);
    const unsigned gen = old / nloc;
    if (old + 1u == (gen + 1u) * nloc) {
      __builtin_amdgcn_fence(__ATOMIC_RELEASE, "agent");
      asm volatile("s_waitcnt vmcnt(0)" ::: "memory");
      const unsigned og = xb_add(&bar[XB_TOP], 1u);
      const unsigned tg = og / nx;
      if (og + 1u == (tg + 1u) * nx) xb_add(&bar[XB_TOPGEN], 1u);
      else XB_SPIN(xb_ld(&bar[XB_TOPGEN]) == tg, bar);
      __builtin_amdgcn_fence(__ATOMIC_ACQUIRE, "agent");
      xb_add(&bar[XB_XGEN(b.x)], 1u);
      asm volatile("s_waitcnt vmcnt(0)" ::: "memory");
    } else {
      XB_SPIN(xb_ld(&bar[XB_XGEN(b.x)]) == gen, bar);
      __builtin_amdgcn_fence(__ATOMIC_ACQUIRE, "agent");
      asm volatile("s_waitcnt vmcnt(0)" ::: "memory");
    }
  }
  __syncthreads();
}

DEV void transpose_tile(const float* __restrict__ src, int sld, bf16_t* __restrict__ dst, int dld, float* lds, int tid) {
  {
    const int c = tid & 63, r0 = tid >> 6;
#pragma unroll
    for (int k = 0; k < 8; ++k) { const int r = r0 + 8 * k; lds[r * 65 + c] = src[(size_t)r * sld + c]; }
  }
  __syncthreads();
  {
    const int r2 = (tid & 31) * 2, c0 = tid >> 5;
#pragma unroll
    for (int k = 0; k < 4; ++k) {
      const int c = c0 + 16 * k;
      *(unsigned*)(dst + (size_t)c * dld + r2) = pk_bf16(lds[r2 * 65 + c], lds[(r2 + 1) * 65 + c]);
    }
  }
  __syncthreads();
}

DEV void transpose_wide(const float* __restrict__ src, int sld, bf16_t* __restrict__ dst, int dld, float* lds, int tid) {
  {
    const int c4 = tid & 63, r0 = tid >> 6;
#pragma unroll 4
    for (int k = 0; k < 8; ++k) {
      const int r = r0 + 8 * k;
      const float4 v = *(const float4*)(src + (size_t)r * sld + c4 * 4);
      float* d = lds + r * 257 + c4 * 4;
      d[0] = v.x; d[1] = v.y; d[2] = v.z; d[3] = v.w;
    }
  }
  __syncthreads();
  {
    const int r2 = (tid & 31) * 2, c0 = tid >> 5;
    const size_t cs = (dld < 0) ? 32 : (size_t)dld;
    bf16_t* dp = (dld < 0) ? dst + (size_t)(r2 >> 5) * 8192 + (r2 & 31) : dst + r2;
#pragma unroll 4
    for (int k = 0; k < 16; ++k) {
      const int c = c0 + 16 * k;
      *(unsigned*)(dp + (size_t)c * cs) = pk_bf16(lds[r2 * 257 + c], lds[(r2 + 1) * 257 + c]);
    }
  }
  __syncthreads();
}
DEV void tpw_mat(const float* src, int R, int C, bf16_t* dst, int dld, int idx, float* lds, int tid) {
  const int ntc = C >> 8, tr = idx / ntc, tc = idx % ntc;
  if (dld < 0) transpose_wide(src + (size_t)tr * 64 * C + tc * 256, C, dst + (size_t)tc * 262144 + (size_t)tr * 2 * 8192, dld, lds, tid);
  else transpose_wide(src + (size_t)tr * 64 * C + tc * 256, C, dst + (size_t)tc * 256 * dld + tr * 64, dld, lds, tid);
}
DEV void tp_mat(const float* src, int R, int C, bf16_t* dst, int dld, int idx, float* lds, int tid) {
  const int ntc = C >> 6, tr = idx / ntc, tc = idx % ntc;
  transpose_tile(src + (size_t)tr * 64 * C + tc * 64, C, dst + (size_t)tc * 64 * dld + tr * 64, dld, lds, tid);
}

DEV void phase_prep(const PV& p, unsigned char* smem) {
  float* lds = (float*)smem;
  const int tid = ltid();
  constexpr int N_ADA = 2 * KS_ADA * 6;
  constexpr int N_TP = 928 + 192 + 128 + 64 + 256 + 256;
  constexpr int N_CV = 256 + 1024;
  constexpr int N_ALL = N_ADA + N_TP + N_CV + 1;
  for (int it = blockIdx.x; it < N_ALL; it += gridDim.x) {
    if (it < N_ADA) {
      const int l = it / 96, cgp = it % 96;
      __syncthreads();
      for (int e = tid; e < 9 * 1024; e += 512) {
        const int j = e >> 10, k = e & 1023;
        const float cv = (j == 0) ? p.IN(8)[k] : p.IN(7)[(j - 1) * 1024 + k];
        lds[e] = cv * sigm(cv);
      }
      __syncthreads();
      const int c = tid & 31, ksl = tid >> 5, col = cgp * 32 + c;
      const float* W = p.IN(10) + (size_t)l * 1024 * 3072 + (size_t)ksl * 64 * 3072 + col;
      float acc[9];
#pragma unroll
      for (int j = 0; j < 9; ++j) acc[j] = 0.f;
#pragma unroll 8
      for (int kk = 0; kk < 64; ++kk) {
        const float w = W[(size_t)kk * 3072];
#pragma unroll
        for (int j = 0; j < 9; ++j) acc[j] += lds[j * 1024 + ksl * 64 + kk] * w;
      }
      float* red = lds + 9 * 1024;
#pragma unroll
      for (int j = 0; j < 9; ++j) red[(ksl * 9 + j) * 32 + c] = acc[j];
      __syncthreads();
      if (tid < 288) {
        const int j = tid >> 5, cc = tid & 31;
        float sum = p.IN(11)[l * 3072 + cgp * 32 + cc];
#pragma unroll
        for (int q = 0; q < 16; ++q) sum += red[(q * 9 + j) * 32 + cc];
        ((float*)(p.WS() + W_MOD))[(size_t)(l * 9 + j) * 3072 + cgp * 32 + cc] = sum;
      }
      __syncthreads();
    } else if (it < N_ADA + N_TP) {
      int x = it - N_ADA;
      if (x < 928) { const int m = x / 464; tpw_mat(p.IN(12) + (size_t)m * 1024 * NCOL, 1024, NCOL, (bf16_t*)(p.WS() + W_WT_IN) + (size_t)m * NCOL * 1024, -1, x % 464, lds, tid); continue; }
      x -= 928;
      if (x < 192) { const int m = x / 32; tpw_mat(p.IN(26) + (size_t)m * 512 * 1024, 512, 1024, (bf16_t*)(p.WS() + W_WT_BR) + (size_t)m * 1024 * 512, 512, x % 32, lds, tid); continue; }
      x -= 192;
      if (x < 128) { const int m = x / 64; tpw_mat(p.IN(27) + (size_t)m * 1024 * 1024, 1024, 1024, (bf16_t*)(p.WS() + W_WT_OUT) + (size_t)m * 1024 * 1024, 1024, x % 64, lds, tid); continue; }
      x -= 128;
      if (x < 64) { const int which = x >> 5, m = x & 31;
        tp_mat(p.IN(which ? 23 : 21) + (size_t)m * 64 * 64, 64, 64, (bf16_t*)(p.WS() + W_WG) + (size_t)m * 128 * 64 + which * 64 * 64, 64, 0, lds, tid); continue; }
      x -= 64;
      if (x < 256) { const int m = x / 16; tp_mat(p.IN(3) + (size_t)m * 512 * 128, 512, 128, (bf16_t*)(p.WS() + W_CVAT) + (size_t)m * 128 * 512, 512, x % 16, lds, tid); continue; }
      x -= 256;
      { const int m = x / 16; tpw_mat(p.IN(5) + (size_t)m * 512 * 512, 512, 512, (bf16_t*)(p.WS() + W_CVBT) + (size_t)m * 512 * 512, 512, x % 16, lds, tid); }
    } else if (it < N_ADA + N_TP + N_CV) {
      int x = it - N_ADA - N_TP;
      const float* src; bf16_t* dst;
      if (x < 256) { src = p.IN(2); dst = (bf16_t*)(p.WS() + W_CKA); } else { x -= 256; src = p.IN(4); dst = (bf16_t*)(p.WS() + W_CKB); }
      const size_t e = (size_t)x * 4096 + tid * 8;
      const float4 a = *(const float4*)(src + e), b = *(const float4*)(src + e + 4);
      uint4 o; o.x = pk_bf16(a.x, a.y); o.y = pk_bf16(a.z, a.w); o.z = pk_bf16(b.x, b.y); o.w = pk_bf16(b.z, b.w);
      *(uint4*)(dst + e) = o;
    } else {
      float* rope = (float*)(p.WS() + W_ROPE);
      for (int e = tid; e < 1024; e += 512) {
        const int pos = e >> 4, i = e & 15;
        const float fr = ex2(-(float)i * (13.287712379549449f / 16.f));
        const float ang = (float)pos * fr;
        rope[e] = __cosf(ang); rope[1024 + e] = __sinf(ang);
      }
      int* ctr = (int*)(p.WS() + W_CTR);
      for (int e = tid; e < 2048; e += 512) ctr[e] = 0;
    }
  }
}

DEV void phase_modfin(const PV& p) {
  const float* mp = (const float*)(p.WS() + W_MODP);
  float* mo = (float*)(p.WS() + W_MOD);
  for (int e = blockIdx.x * 512 + ltid(); e < 2 * 9 * 3072; e += gridDim.x * 512) {
    const int l = e / (9 * 3072), rem = e % (9 * 3072), col = rem % 3072;
    float s = p.IN(11)[l * 3072 + col];
    for (int ks = 0; ks < KS_ADA; ++ks) s += mp[(size_t)ks * 2 * 9 * 3072 + (size_t)l * 9 * 3072 + rem];
    mo[e] = s;
  }
}

DEV void phase_norm(const PV& p, int stream, int l) {
  const int tix = ltid(); const int lane = tix & 63, wv = tix >> 6;
  const float* xin = (l == 0) ? p.IN(stream) : (p.OUT() + (size_t)stream * 8388608);
  const float* g = p.IN(9) + l * 1024;
  bf16_t* H = (bf16_t*)(p.WS() + W_H);
  const float* mod = (const float*)(p.WS() + W_MOD);
  for (int row = blockIdx.x * 8 + wv; row < NTOK; row += gridDim.x * 8) {
    const int j = stream ? 1 + (row >> 10) : 0;
    const float* mj = mod + (size_t)(l * 9 + j) * 3072;
    const float* xr = xin + (size_t)row * 1024;
    float4 xv[4]; float ss = 0.f;
#pragma unroll
    for (int q = 0; q < 4; ++q) { xv[q] = *(const float4*)(xr + q * 256 + lane * 4); ss += xv[q].x * xv[q].x + xv[q].y * xv[q].y + xv[q].z * xv[q].z + xv[q].w * xv[q].w; }
#pragma unroll
    for (int o = 32; o >= 1; o >>= 1) ss += __shfl_xor(ss, o);
    const float rstd = rsqrtf(ss * (1.f / 1024.f) + 1e-6f);
#pragma unroll
    for (int q = 0; q < 4; ++q) {
      const int col = q * 256 + lane * 4;
      const float4 gv = *(const float4*)(g + col), sh = *(const float4*)(mj + col), sc = *(const float4*)(mj + 1024 + col);
      store_bf16x4(H + ((size_t)((row >> 8) * 32 + (col >> 5)) * 256 + (row & 255)) * 32 + (col & 31),
                   xv[q].x * rstd * gv.x * (1.f + sc.x) + sh.x, xv[q].y * rstd * gv.y * (1.f + sc.y) + sh.y,
                   xv[q].z * rstd * gv.z * (1.f + sc.z) + sh.z, xv[q].w * rstd * gv.w * (1.f + sc.w) + sh.w);
    }
  }
}

DEV void gemm_stage(const bf16_t* A, int lda, const bf16_t* Bt, int ldb, int k0, unsigned char* st, int tid) {
#pragma unroll
  for (int i = 0; i < 4; ++i) {
    const int pp = i * 512 + tid, row = pp >> 3, ch = (pp & 7) ^ (row & 7);
    __builtin_amdgcn_global_load_lds((const void*)(A + (size_t)row * lda + k0 + ch * 8), (LAS void*)(st + pp * 16), 16, 0, 0);
  }
#pragma unroll
  for (int i = 0; i < 2; ++i) {
    const int pp = i * 512 + tid, row = pp >> 3, ch = (pp & 7) ^ (row & 7);
    __builtin_amdgcn_global_load_lds((const void*)(Bt + (size_t)row * ldb + k0 + ch * 8), (LAS void*)(st + GA_BYTES + pp * 16), 16, 0, 0);
  }
}

DEV void gemm_compute(const unsigned char* st, f32x4 (&acc)[4][4], int wr, int wc, int fr, int quad) {
#pragma unroll
  for (int ks = 0; ks < 2; ++ks) {
    bf16x8 af[4], bfr[4];
    const int ch = ((ks * 4 + quad) ^ (fr & 7)) * 16;
#pragma unroll
    for (int m = 0; m < 4; ++m) af[m] = *(const bf16x8*)(st + (wr * 64 + m * 16 + fr) * 128 + ch);
#pragma unroll
    for (int n = 0; n < 4; ++n) bfr[n] = *(const bf16x8*)(st + GA_BYTES + (wc * 64 + n * 16 + fr) * 128 + ch);
#pragma unroll
    for (int m = 0; m < 4; ++m)
#pragma unroll
      for (int n = 0; n < 4; ++n) acc[m][n] = mfma16(bfr[n], af[m], acc[m][n]);
  }
}

DEV void gemm_kloop(const bf16_t* A, int lda, const bf16_t* Bt, int ldb, int K, unsigned char* smem, f32x4 (&acc)[4][4], int wr, int wc, int fr, int quad, int tid) {
  const int nt = K >> 6;
  asm volatile("s_waitcnt vmcnt(0)" ::: "memory");
  __syncthreads();
  gemm_stage(A, lda, Bt, ldb, 0, smem, tid);
  gemm_stage(A, lda, Bt, ldb, 64, smem + GSTAGE, tid);
  int cur = 0;
  for (int t = 0; t < nt; ++t) {
    if (t + 1 < nt) asm volatile("s_waitcnt vmcnt(6)" ::: "memory"); else asm volatile("s_waitcnt vmcnt(0)" ::: "memory");
    __builtin_amdgcn_s_barrier();
    if (t + 2 < nt) { int nb = cur + 2; nb = (nb >= 3) ? nb - 3 : nb; gemm_stage(A, lda, Bt, ldb, (t + 2) * 64, smem + nb * GSTAGE, tid); }
    gemm_compute(smem + cur * GSTAGE, acc, wr, wc, fr, quad);
    cur = (cur == 2) ? 0 : cur + 1;
  }
  __syncthreads();
}

DEV void inproj_epilogue_rows(const PV& p, int stream, int l, int tok, int pn, int cl, int hf, const float* eprow, unsigned char* orow) {
  const int col = pn * 128 + cl;
  float v[32];
#pragma unroll
  for (int q = 0; q < 8; ++q) { const float4 t4 = *(const float4*)(eprow + q * 4); v[q * 4] = t4.x; v[q * 4 + 1] = t4.y; v[q * 4 + 2] = t4.z; v[q * 4 + 3] = t4.w; }
  bf16_t* P = (bf16_t*)(p.WS() + W_P);
  const int T = stream ? 1024 : 256;
  const int bb = stream ? (tok >> 10) : (tok >> 8), tt = stream ? (tok & 1023) : (tok & 255);
  const bool isQK = (pn <= 4) || (pn >= 10 && pn < 18);
  const bool isV = (pn == 5) || (pn >= 18 && pn < 22);
  if (isQK) {
    const float* nw = ((pn < 4) ? p.IN(13) : (pn == 4) ? p.IN(14) : (pn < 14) ? p.IN(16) : p.IN(17)) + l * 64 + hf * 32;
    float ss = 0.f;
#pragma unroll
    for (int i = 0; i < 32; ++i) ss += v[i] * v[i];
    ss += __shfl_xor(ss, 1);
    const float rstd = rsqrtf(ss * (1.f / 64.f) + 1e-6f);
#pragma unroll
    for (int i = 0; i < 32; ++i) v[i] = v[i] * rstd * nw[i];
    if (stream && pn <= 4) {
      const int pos = hf ? (tt & 63) : (tt >> 6);
      const float* rc = (const float*)(p.WS() + W_ROPE) + pos * 16;
#pragma unroll
      for (int i = 0; i < 16; ++i) {
        const float c = rc[i], s = rc[1024 + i], x1 = v[i], x2 = v[16 + i];
        v[i] = x1 * c - x2 * s; v[16 + i] = x2 * c + x1 * s;
      }
    }
  }
  if (!stream) {
    float* dst = nullptr;
    if (pn == 4) dst = p.OUT() + O_KA + ((size_t)(bb * 2 + l) * 256 + tt) * 128 + cl;
    else if (pn == 5) dst = p.OUT() + O_VA + ((size_t)(bb * 2 + l) * 256 + tt) * 128 + cl;
    else if (pn >= 14 && pn < 18) dst = p.OUT() + O_KB + ((size_t)(bb * 2 + l) * 256 + tt) * 512 + (pn - 14) * 128 + cl;
    else if (pn >= 18 && pn < 22) dst = p.OUT() + O_VB + ((size_t)(bb * 2 + l) * 256 + tt) * 512 + (pn - 18) * 128 + cl;
    if (dst) {
#pragma unroll
      for (int q = 0; q < 8; ++q) *(float4*)(dst + q * 4) = make_float4(v[q * 4], v[q * 4 + 1], v[q * 4 + 2], v[q * 4 + 3]);
    }
  }
  if (isV) return;
  if (!isQK) {
    const bool silu = (pn >= 6 && pn < 10) || (pn >= 22 && pn < 26) || (pn >= 30 && pn < 34);
    const bool sg = (pn >= 34);
    if (silu) {
#pragma unroll
      for (int i = 0; i < 32; ++i) v[i] = v[i] * sigm(v[i]);
    } else if (sg) {
#pragma unroll
      for (int i = 0; i < 32; ++i) v[i] = sigm(v[i]);
    }
  }
#pragma unroll
  for (int q = 0; q < 4; ++q) {
    uint4 o; o.x = pk_bf16(v[q * 8], v[q * 8 + 1]); o.y = pk_bf16(v[q * 8 + 2], v[q * 8 + 3]); o.z = pk_bf16(v[q * 8 + 4], v[q * 8 + 5]); o.w = pk_bf16(v[q * 8 + 6], v[q * 8 + 7]);
    *(uint4*)(orow + q * 16) = o;
  }
}

constexpr int G2_STAGE = 32768;
DEV void g2_stage(const bf16_t* A, int lda, const bf16_t* Bt, int ldb, int k0, unsigned char* st, int tid) {
  const int ko = k0 * 256;
#pragma unroll
  for (int i = 0; i < 2; ++i) {
    const int pp = i * 512 + tid, row = pp >> 2, ch = (pp & 3) ^ ((row >> 2) & 3);
    __builtin_amdgcn_global_load_lds((const void*)(A + (size_t)row * 32 + ko + ch * 8), (LAS void*)(st + pp * 16), 16, 0, 0);
  }
#pragma unroll
  for (int i = 0; i < 2; ++i) {
    const int pp = i * 512 + tid, row = pp >> 2, ch = (pp & 3) ^ ((row >> 2) & 3);
    __builtin_amdgcn_global_load_lds((const void*)(Bt + (size_t)row * 32 + ko + ch * 8), (LAS void*)(st + 16384 + pp * 16), 16, 0, 0);
  }
}
struct G2B { bf16x8 v[4]; };
struct G2A { bf16x8 v[4]; };
DEV void g2_read_b(G2B& f, const unsigned char* st, int wc, int fr, int quad) {
  const int ch = (quad ^ ((fr >> 2) & 3)) * 16;
#pragma unroll
  for (int n = 0; n < 4; ++n) f.v[n] = *(const bf16x8*)(st + 16384 + (wc * 64 + n * 16 + fr) * 64 + ch);
}
DEV void g2_read_a(G2A& f, const unsigned char* st, int half, int wr, int fr, int quad) {
  const int ch = (quad ^ ((fr >> 2) & 3)) * 16;
#pragma unroll
  for (int m = 0; m < 4; ++m) f.v[m] = *(const bf16x8*)(st + (wr * 128 + (half * 4 + m) * 16 + fr) * 64 + ch);
}
template <int HALF>
DEV void g2_mma(const G2B& b, const G2A& a, f32x4 (&acc)[8][4]) {
#pragma unroll
  for (int m = 0; m < 4; ++m)
#pragma unroll
    for (int n = 0; n < 4; ++n) acc[HALF * 4 + m][n] = mfma16(b.v[n], a.v[m], acc[HALF * 4 + m][n]);
}
DEV void g2_kloop(const bf16_t* A, int lda, const bf16_t* Bt, int ldb, int K, unsigned char* smem, f32x4 (&acc)[8][4], int wr, int wc, int fr, int quad, int tid) {
  const int nt = K >> 5;
  asm volatile("s_waitcnt vmcnt(0)" ::: "memory");
  __syncthreads();
  g2_stage(A, lda, Bt, ldb, 0, smem, tid);
  g2_stage(A, lda, Bt, ldb, 32, smem + G2_STAGE, tid);
  g2_stage(A, lda, Bt, ldb, 64, smem + 2 * G2_STAGE, tid);
  asm volatile("s_waitcnt vmcnt(8)" ::: "memory");
  __builtin_amdgcn_s_barrier();
  G2B bb; G2A a0, a1;
  g2_read_b(bb, smem, wc, fr, quad);
  g2_read_a(a0, smem, 0, wr, fr, quad);
  for (int t = 0; t < nt; ++t) {
    const bool more = (t + 1 < nt);
    if (more) {
      if (t + 2 < nt) asm volatile("s_waitcnt vmcnt(4)" ::: "memory"); else asm volatile("s_waitcnt vmcnt(0)" ::: "memory");
      asm volatile("s_waitcnt lgkmcnt(0)" ::: "memory");
      __builtin_amdgcn_s_barrier();
      if (t + 3 < nt) g2_stage(A, lda, Bt, ldb, (t + 3) * 32, smem + ((t + 3) & 3) * G2_STAGE, tid);
    }
    g2_read_a(a1, smem + (t & 3) * G2_STAGE, 1, wr, fr, quad);
    g2_mma<0>(bb, a0, acc);
    if (more) g2_read_a(a0, smem + ((t + 1) & 3) * G2_STAGE, 0, wr, fr, quad);
    g2_mma<1>(bb, a1, acc);
    if (more) g2_read_b(bb, smem + ((t + 1) & 3) * G2_STAGE, wc, fr, quad);
  }
  __syncthreads();
}

constexpr int EP2_LD = 260;
DEV void phase_inproj(const PV& p, int stream, int l, unsigned char* smem) {
  const int tix = ltid(); const int lane = tix & 63, wv = tix >> 6, wr = wv >> 2, wc = wv & 3, fr = lane & 15, quad = lane >> 4;
  const bf16_t* H = (const bf16_t*)(p.WS() + W_H);
  const bf16_t* Wt = (const bf16_t*)(p.WS() + W_WT_IN) + (size_t)l * NCOL * 1024;
  float* ep = (float*)smem;
  unsigned char* ost = smem + 64 * EP2_LD * 4;
  constexpr int OST_LD = 528;
  for (int t = blockIdx.x; t < 4 * 256; t += gridDim.x) {
    const int rr = t >> 8, xcd = t & 7, j = (t & 255) >> 3, jj = j >> 2;
    const int pm = xcd * 4 + (j & 3);
    int pn;
    if (jj >= 5) { if (rr >= 3) continue; const int h = rr * 3 + (jj - 5); pn = (h < 3) ? h : h + 2; }
    else { const int q = rr * 5 + jj; pn = (q < 2) ? q + 3 : q + 9; }
    f32x4 acc[8][4];
#pragma unroll
    for (int m = 0; m < 8; ++m)
#pragma unroll
      for (int n = 0; n < 4; ++n) acc[m][n] = (f32x4){0.f, 0.f, 0.f, 0.f};
    g2_kloop(H + (size_t)pm * 256 * 1024, 1024, Wt + (size_t)pn * 256 * 1024, 1024, 1024, smem, acc, wr, wc, fr, quad, tix);
    if (pn == 3 || pn == 4 || pn >= 11) {
      const int act = (pn == 13 || pn == 14) ? 0 : ((pn >= 17) ? 2 : 1);
#pragma unroll
      for (int m = 0; m < 8; ++m)
#pragma unroll
        for (int n = 0; n < 4; ++n) {
          float v0 = acc[m][n][0], v1 = acc[m][n][1], v2 = acc[m][n][2], v3 = acc[m][n][3];
          if (act) {
            const float s0 = sigm(v0), s1 = sigm(v1), s2 = sigm(v2), s3 = sigm(v3);
            if (act == 1) { v0 *= s0; v1 *= s1; v2 *= s2; v3 *= s3; } else { v0 = s0; v1 = s1; v2 = s2; v3 = s3; }
          }
          uint2 o; o.x = pk_bf16(v0, v1); o.y = pk_bf16(v2, v3);
          *(uint2*)(smem + (wr * 128 + m * 16 + fr) * 528 + (wc * 64 + n * 16 + 4 * quad) * 2) = o;
        }
      __syncthreads();
      bf16_t* Pw = (bf16_t*)(p.WS() + W_P) + (size_t)(pm * 256) * NCOL + pn * 256;
#pragma unroll 4
      for (int k = 0; k < 16; ++k) {
        const int idx = k * 512 + tix, row = idx >> 5, ch = idx & 31;
        *(uint4*)(Pw + (size_t)row * NCOL + ch * 8) = *(const uint4*)(smem + row * 528 + ch * 16);
      }
      continue;
    }
#pragma unroll
    for (int pass = 0; pass < 4; ++pass) {
      if (wr == (pass >> 1)) {
#pragma unroll
        for (int mm = 0; mm < 4; ++mm)
#pragma unroll
          for (int n = 0; n < 4; ++n) *(f32x4*)(ep + (mm * 16 + fr) * EP2_LD + wc * 64 + n * 16 + 4 * quad) = acc[(pass & 1) * 4 + mm][n];
      }
      __syncthreads();
      {
        const int r = tix >> 3, cg4 = (tix >> 1) & 3, hf = tix & 1;
        inproj_epilogue_rows(p, stream, l, pm * 256 + pass * 64 + r, pn * 2 + (cg4 >> 1), (cg4 & 1) * 64 + hf * 32, hf, ep + r * EP2_LD + cg4 * 64 + hf * 32,
                             ost + r * OST_LD + cg4 * 128 + hf * 64);
      }
      if (pn == 2 || pn == 9 || pn == 10) {
        const int c = tix >> 1, hfr = tix & 1, pn128 = pn * 2 + (c >> 7), cl = c & 127;
        if (pn128 == 5 || pn128 >= 18) {
          const int T = stream ? 1024 : 256;
          const int tok0 = pm * 256 + pass * 64 + hfr * 32;
          const int bb = stream ? (tok0 >> 10) : (tok0 >> 8), tt0 = stream ? (tok0 & 1023) : (tok0 & 255);
          bf16_t* vt = (pn128 == 5) ? (bf16_t*)(p.WS() + W_VAT) + ((size_t)bb * 128 + cl) * T + tt0
                                    : (bf16_t*)(p.WS() + W_VBT) + ((size_t)bb * 512 + (pn128 - 18) * 128 + cl) * T + tt0;
          const float* ec = ep + (hfr * 32) * EP2_LD + c;
#pragma unroll
          for (int q = 0; q < 4; ++q) {
            uint4 o;
            o.x = pk_bf16(ec[(q * 8 + 0) * EP2_LD], ec[(q * 8 + 1) * EP2_LD]); o.y = pk_bf16(ec[(q * 8 + 2) * EP2_LD], ec[(q * 8 + 3) * EP2_LD]);
            o.z = pk_bf16(ec[(q * 8 + 4) * EP2_LD], ec[(q * 8 + 5) * EP2_LD]); o.w = pk_bf16(ec[(q * 8 + 6) * EP2_LD], ec[(q * 8 + 7) * EP2_LD]);
            *(uint4*)(vt + q * 8) = o;
          }
        }
      }
      __syncthreads();
      {
        bf16_t* Pw = (bf16_t*)(p.WS() + W_P) + (size_t)(pm * 256 + pass * 64) * NCOL + pn * 256;
#pragma unroll 1
        for (int k = 0; k < 4; ++k) {
          const int idx = k * 512 + tix, row = idx >> 5, ch = idx & 31;
          const int pn128 = pn * 2 + (ch >> 4);
          if (!(pn128 == 5 || (pn128 >= 18 && pn128 < 22))) *(uint4*)(Pw + (size_t)row * NCOL + ch * 8) = *(const uint4*)(ost + row * OST_LD + ch * 16);
        }
      }
      __syncthreads();
    }
  }
}

constexpr int AT_BUF = 16384;
constexpr int AT_RPB = 32768;
constexpr int AT_LRU = 36864;
constexpr int AT_MISC = 53248;

template <int NQ> struct AttnState { bf16x8 qf[NQ][2]; f32x4 o[NQ][4]; float m[NQ], l[NQ]; };
struct ChunkSrc { const bf16_t* K; int ldk; const bf16_t* VT; int ldvt; };

template <int NQ>
DEV void attn_init(AttnState<NQ>& st, const bf16_t* Q, int fr, int quad, float m0, float l0) {
#pragma unroll
  for (int nq = 0; nq < NQ; ++nq) {
#pragma unroll
    for (int ks = 0; ks < 2; ++ks) {
      const uint4 raw = *(const uint4*)(Q + (size_t)(nq * 16 + fr) * NCOL + ks * 32 + quad * 8);
      const unsigned w[4] = {raw.x, raw.y, raw.z, raw.w};
      union { bf16x8 v; unsigned u[4]; } qq;
#pragma unroll
      for (int e = 0; e < 4; ++e) qq.u[e] = pk_bf16(__uint_as_float(w[e] << 16) * (0.125f * LOG2E), __uint_as_float(w[e] & 0xffff0000u) * (0.125f * LOG2E));
      st.qf[nq][ks] = qq.v;
    }
#pragma unroll
    for (int mb = 0; mb < 4; ++mb) st.o[nq][mb] = (f32x4){0.f, 0.f, 0.f, 0.f};
    st.m[nq] = m0; st.l[nq] = (quad == 0) ? l0 : 0.f;
  }
}

DEV void attn_stage(const ChunkSrc& c, unsigned char* buf, int tid) {
  const int row = tid >> 3, ch = (tid & 7) ^ (row & 7);
  __builtin_amdgcn_global_load_lds((const void*)(c.K + (size_t)row * c.ldk + ch * 8), (LAS void*)(buf + tid * 16), 16, 0, 0);
  __builtin_amdgcn_global_load_lds((const void*)(c.VT + (size_t)row * c.ldvt + ch * 8), (LAS void*)(buf + 8192 + tid * 16), 16, 0, 0);
}

template <int NQ, class F>
DEV void attn_chunk(AttnState<NQ>& st, const unsigned char* buf, int fr, int quad, int gmask, F&& bias) {
  const int sw = fr & 7;
  float sv[NQ][2][8];
#pragma unroll
  for (int g = 0; g < 2; ++g) {
    if (!((gmask >> g) & 1)) continue;
    bf16x8 kf[2][2];
#pragma unroll
    for (int bl = 0; bl < 2; ++bl)
#pragma unroll
      for (int ks = 0; ks < 2; ++ks) kf[bl][ks] = *(const bf16x8*)(buf + ((g * 2 + bl) * 16 + fr) * 128 + (((ks * 4 + quad) ^ sw) * 16));
#pragma unroll
    for (int nq = 0; nq < NQ; ++nq)
#pragma unroll
      for (int bl = 0; bl < 2; ++bl) {
        f32x4 s = mfma16(kf[bl][0], st.qf[nq][0], (f32x4){0.f, 0.f, 0.f, 0.f});
        s = mfma16(kf[bl][1], st.qf[nq][1], s);
#pragma unroll
        for (int i = 0; i < 4; ++i) sv[nq][g][bl * 4 + i] = bias(nq, g * 32 + bl * 16 + 4 * quad + i, s[i]);
      }
  }
  float alpha[NQ];
#pragma unroll
  for (int nq = 0; nq < NQ; ++nq) {
    float mx = -3.0e38f;
#pragma unroll
    for (int g = 0; g < 2; ++g) {
      if (!((gmask >> g) & 1)) continue;
#pragma unroll
      for (int i = 0; i < 8; ++i) mx = fmaxf(mx, sv[nq][g][i]);
    }
    mx = quad_max(mx);
    const float mn = fmaxf(st.m[nq], mx);
    alpha[nq] = ex2(st.m[nq] - mn);
    st.m[nq] = mn;
    float ps = 0.f;
#pragma unroll
    for (int g = 0; g < 2; ++g) {
      if (!((gmask >> g) & 1)) continue;
#pragma unroll
      for (int i = 0; i < 8; ++i) { sv[nq][g][i] = ex2(sv[nq][g][i] - mn); ps += sv[nq][g][i]; }
    }
    st.l[nq] = st.l[nq] * alpha[nq] + ps;
#pragma unroll
    for (int mb = 0; mb < 4; ++mb) { st.o[nq][mb][0] *= alpha[nq]; st.o[nq][mb][1] *= alpha[nq]; st.o[nq][mb][2] *= alpha[nq]; st.o[nq][mb][3] *= alpha[nq]; }
  }
#pragma unroll
  for (int g = 0; g < 2; ++g) {
    if (!((gmask >> g) & 1)) continue;
    bf16x8 vf[4];
#pragma unroll
    for (int mb = 0; mb < 4; ++mb) {
      const unsigned char* vr = buf + 8192 + (mb * 16 + fr) * 128 + (quad & 1) * 8;
      const bf16x4 lo = *(const bf16x4*)(vr + (((g * 4 + (quad >> 1)) ^ sw) * 16));
      const bf16x4 hi = *(const bf16x4*)(vr + (((g * 4 + 2 + (quad >> 1)) ^ sw) * 16));
      vf[mb] = (bf16x8){lo[0], lo[1], lo[2], lo[3], hi[0], hi[1], hi[2], hi[3]};
    }
#pragma unroll
    for (int nq = 0; nq < NQ; ++nq) {
      union { bf16x8 v; unsigned u[4]; } pb;
      pb.u[0] = pk_bf16(sv[nq][g][0], sv[nq][g][1]); pb.u[1] = pk_bf16(sv[nq][g][2], sv[nq][g][3]);
      pb.u[2] = pk_bf16(sv[nq][g][4], sv[nq][g][5]); pb.u[3] = pk_bf16(sv[nq][g][6], sv[nq][g][7]);
#pragma unroll
      for (int mb = 0; mb < 4; ++mb) st.o[nq][mb] = mfma16(vf[mb], pb.v, st.o[nq][mb]);
    }
  }
}

constexpr int AT_GATE = 65536, AT_OUT = 98304;
template <int NQ>
DEV void attn_gate_prefetch(const bf16_t* row0, int gcol, unsigned char* wg, int lane) {
#pragma unroll
  for (int k = 0; k < NQ * 2; ++k) {
    const int idx = k * 64 + lane, row = idx >> 3, ch = (idx & 7) ^ (row & 7);
    __builtin_amdgcn_global_load_lds((const void*)(row0 + (size_t)row * NCOL + gcol + ch * 8), (LAS void*)(wg + idx * 16), 16, 0, 0);
  }
}
template <int NQ>
DEV void attn_finish(AttnState<NQ>& st, const unsigned char* wg, unsigned char* wo, bf16_t* yrow0, int ycol, int lane, int fr, int quad) {
#pragma unroll
  for (int nq = 0; nq < NQ; ++nq) {
    float l = st.l[nq];
    l += __shfl_xor(l, 16); l += __shfl_xor(l, 32);
    const float inv = 1.f / l;
    const int row = nq * 16 + fr;
#pragma unroll
    for (int mb = 0; mb < 4; ++mb) {
      const int d0 = mb * 16 + 4 * quad;
      const int off = row * 128 + ((((d0 >> 3) ^ (row & 7))) << 4) + ((d0 & 7) << 1);
      const bf16x4 g = *(const bf16x4*)(wg + off);
      const f32x4 o = st.o[nq][mb];
      uint2 v; v.x = pk_bf16(o[0] * inv * bf2f((unsigned short)g[0]), o[1] * inv * bf2f((unsigned short)g[1]));
      v.y = pk_bf16(o[2] * inv * bf2f((unsigned short)g[2]), o[3] * inv * bf2f((unsigned short)g[3]));
      *(uint2*)(wo + off) = v;
    }
  }
  __builtin_amdgcn_fence(__ATOMIC_RELEASE, "wavefront");
  __builtin_amdgcn_wave_barrier();
  __builtin_amdgcn_fence(__ATOMIC_ACQUIRE, "wavefront");
#pragma unroll
  for (int k = 0; k < NQ * 2; ++k) {
    const int idx = k * 64 + lane, row = idx >> 3, ch = idx & 7;
    *(uint4*)(yrow0 + (size_t)row * 1024 + ycol + ch * 8) = *(const uint4*)(wo + row * 128 + ((ch ^ (row & 7)) << 4));
  }
  __builtin_amdgcn_wave_barrier();
}

template <class S, class B>
DEV void attn_pipeline(int nch, unsigned char* smem, int tid, S&& src, B&& body) {
  attn_stage(src(0), smem, tid);
  for (int c = 0; c < nch; ++c) {
    asm volatile("s_waitcnt vmcnt(0)" ::: "memory");
    __syncthreads();
    if (c + 1 < nch) attn_stage(src(c + 1), smem + ((c + 1) & 1) * AT_BUF, tid);
    body(c, smem + (c & 1) * AT_BUF);
  }
  asm volatile("s_waitcnt vmcnt(0)" ::: "memory");
  __syncthreads();
}

DEV void attn_ctx_item(const PV& p, int l, int item, unsigned char* smem, int tid, int wv, int fr, int quad) {
  bf16_t* P = (bf16_t*)(p.WS() + W_P);
  const int isB = item >> 8, x = item & 255, b = x >> 3, sub = x & 7;
  int hq, tok0, qcol, gcol; const bf16_t *K, *VT; float m0, l0;
  if (!isB) {
    const int kvh = sub >> 2, qb = sub & 3;
    hq = kvh * 4 + (wv >> 1); tok0 = b * 256 + qb * 64 + (wv & 1) * 32;
    qcol = C_AQ + hq * 64; gcol = C_AG + hq * 64;
    K = P + (size_t)b * 256 * NCOL + C_AK + kvh * 64;
    VT = (const bf16_t*)(p.WS() + W_VAT) + ((size_t)b * 128 + kvh * 64) * 256;
    m0 = p.IN(15)[l * 8 + hq] * LOG2E; l0 = 1.f;
  } else {
    hq = sub; tok0 = b * 256 + wv * 32;
    qcol = C_BQ + hq * 64; gcol = C_BG + hq * 64;
    K = P + (size_t)b * 256 * NCOL + C_BK + hq * 64;
    VT = (const bf16_t*)(p.WS() + W_VBT) + ((size_t)b * 512 + hq * 64) * 256;
    m0 = -1e30f; l0 = 0.f;
  }
  bf16_t* row0 = P + (size_t)tok0 * NCOL;
  AttnState<2> st;
  attn_init<2>(st, row0 + qcol, fr, quad, m0, l0);
  attn_gate_prefetch<2>(row0, gcol, smem + AT_GATE + wv * 4096, tid & 63);
  attn_pipeline(4, smem, tid,
                [&](int c) { return ChunkSrc{K + (size_t)c * 64 * NCOL, NCOL, VT + c * 64, 256}; },
                [&](int, const unsigned char* buf) { attn_chunk<2>(st, buf, fr, quad, 3, [](int, int, float v) { return v; }); });
  attn_finish<2>(st, smem + AT_GATE + wv * 4096, smem + AT_OUT + wv * 4096, (bf16_t*)(p.WS() + W_Y) + (size_t)tok0 * 1024, isB * 512 + hq * 64, tid & 63, fr, quad);
}

DEV void attn_latA_item(const PV& p, int l, int item, unsigned char* smem, int tid, int wv, int fr, int quad) {
  bf16_t* P = (bf16_t*)(p.WS() + W_P);
  const int b = item >> 5, kvh = (item >> 4) & 1, qb = item & 15;
  const int hq = kvh * 4 + (wv >> 1), q0w = qb * 64 + (wv & 1) * 32;
  bf16_t* row0 = P + (size_t)(b * 1024 + q0w) * NCOL;
  const int qcol = C_AQ + hq * 64, gcol = C_AG + hq * 64;
  AttnState<2> st;
  attn_init<2>(st, row0 + qcol, fr, quad, p.IN(15)[l * 8 + hq] * LOG2E, 1.f);
  attn_gate_prefetch<2>(row0, gcol, smem + AT_GATE + wv * 4096, tid & 63);
  const bf16_t* Kc = (const bf16_t*)(p.WS() + W_CKA) + (size_t)(b * 2 + l) * 512 * 128 + kvh * 64;
  const bf16_t* VTc = (const bf16_t*)(p.WS() + W_CVAT) + ((size_t)(b * 2 + l) * 128 + kvh * 64) * 512;
  const bf16_t* Kl = P + (size_t)b * 1024 * NCOL + C_AK + kvh * 64;
  const bf16_t* VTl = (const bf16_t*)(p.WS() + W_VAT) + ((size_t)b * 128 + kvh * 64) * 1024;
  const int k_lo = (qb * 64 - 128 < 0) ? 0 : qb * 64 - 128, k_hi = (qb * 64 + 192 > 1024) ? 1024 : qb * 64 + 192;
  const int nch = 8 + ((k_hi - k_lo) >> 6);
  attn_pipeline(nch, smem, tid,
                [&](int c) { if (c < 8) return ChunkSrc{Kc + (size_t)c * 64 * 128, 128, VTc + c * 64, 512};
                             const int k0 = k_lo + (c - 8) * 64; return ChunkSrc{Kl + (size_t)k0 * NCOL, NCOL, VTl + k0, 1024}; },
                [&](int c, const unsigned char* buf) {
                  if (c < 8) { attn_chunk<2>(st, buf, fr, quad, 3, [](int, int, float v) { return v; }); return; }
                  const int k0 = k_lo + (c - 8) * 64;
                  int gm = 0;
                  if (k0 + 31 >= q0w - 128 && k0 <= q0w + 31 + 128) gm |= 1;
                  if (k0 + 63 >= q0w - 128 && k0 + 32 <= q0w + 31 + 128) gm |= 2;
                  attn_chunk<2>(st, buf, fr, quad, gm, [&](int nq, int kk, float v) { const int dd = (q0w + nq * 16 + fr) - (k0 + kk); return (dd <= 128 && dd >= -128) ? v : -1e30f; });
                });
  attn_finish<2>(st, smem + AT_GATE + wv * 4096, smem + AT_OUT + wv * 4096, (bf16_t*)(p.WS() + W_Y) + (size_t)(b * 1024 + q0w) * 1024, hq * 64, tid & 63, fr, quad);
}

DEV void attn_latB_item(const PV& p, int l, int item, unsigned char* smem, int tid, int wv, int fr, int quad) {
  bf16_t* P = (bf16_t*)(p.WS() + W_P);
  const int b = item >> 6, h = (item >> 3) & 7, rp = item & 7;
  const int r = 2 * rp + (wv >> 2), jb = wv & 3;
  bf16_t* row0 = P + (size_t)(b * 1024 + r * 64 + jb * 16) * NCOL;
  const int qcol = C_BQ + h * 64, gcol = C_BG + h * 64;
  float* rpl = (float*)(smem + AT_RPB);
  { const float* rpb = p.IN(18) + (size_t)(l * 8 + h) * 15 * 31; if (tid < 465) rpl[tid] = rpb[tid]; }
  AttnState<1> st;
  attn_init<1>(st, row0 + qcol, fr, quad, -1e30f, 0.f);
  attn_gate_prefetch<1>(row0, gcol, smem + AT_GATE + wv * 4096, tid & 63);
  const bf16_t* Kc = (const bf16_t*)(p.WS() + W_CKB) + (size_t)(b * 2 + l) * 512 * 512 + h * 64;
  const bf16_t* VTc = (const bf16_t*)(p.WS() + W_CVBT) + ((size_t)(b * 2 + l) * 512 + h * 64) * 512;
  const bf16_t* Kl = P + (size_t)b * 1024 * NCOL + C_BK + h * 64;
  const bf16_t* VTl = (const bf16_t*)(p.WS() + W_VBT) + ((size_t)b * 512 + h * 64) * 1024;
  const int r0 = 2 * rp;
  const int rs0 = (r0 - 4 < 0) ? 0 : ((r0 - 4 > 8) ? 8 : r0 - 4);
  const int rs1 = (r0 - 3 < 0) ? 0 : ((r0 - 3 > 8) ? 8 : r0 - 3);
  const int rs = (wv >> 2) ? rs1 : rs0;
  const int nch = 8 + (rs1 + 8 - rs0);
  const int qc = jb * 16 + fr;
  const int cs = (qc - 8 < 0) ? 0 : ((qc - 8 > 48) ? 48 : qc - 8);
  const int gmw = (jb == 0) ? 1 : ((jb == 3) ? 2 : 3);
  attn_pipeline(nch, smem, tid,
                [&](int c) { if (c < 8) return ChunkSrc{Kc + (size_t)c * 64 * 512, 512, VTc + c * 64, 512};
                             const int key0 = (rs0 + c - 8) * 64; return ChunkSrc{Kl + (size_t)key0 * NCOL, NCOL, VTl + key0, 1024}; },
                [&](int c, const unsigned char* buf) {
                  if (c < 8) { attn_chunk<1>(st, buf, fr, quad, 3, [](int, int, float v) { return v; }); return; }
                  const int krow = rs0 + c - 8;
                  if (krow < rs || krow >= rs + 8) return;
                  const float* rp_ = rpl + (krow - r + 7) * 31;
                  attn_chunk<1>(st, buf, fr, quad, gmw, [&](int, int kc, float v) {
                    int dc = kc - qc + 15; dc = dc < 0 ? 0 : (dc > 30 ? 30 : dc);
                    const float bv = rp_[dc];
                    return (kc >= cs && kc < cs + 16) ? v + bv * LOG2E : -1e30f; });
                });
  attn_finish<1>(st, smem + AT_GATE + wv * 4096, smem + AT_OUT + wv * 4096, (bf16_t*)(p.WS() + W_Y) + (size_t)(b * 1024 + r * 64 + jb * 16) * 1024, 512 + h * 64, tid & 63, fr, quad);
}

DEV void lru_load(const bf16_t* P, size_t tokbase, int T, int t0, int quad, int ch0, uint2 (&cx)[7]) {
#pragma unroll
  for (int rr = 0; rr < 7; ++rr) {
    const int t = t0 + 4 * quad - 2 + rr;
    cx[rr] = make_uint2(0u, 0u);
    if (t >= 0 && t < T) cx[rr] = *(const uint2*)(P + (tokbase + t) * NCOL + C_CX + ch0);
  }
}

DEV void lru_item(const PV& p, int stream, int l, int item, unsigned char* wl, int lane, int fr, int quad) {
  const int dir = item & 1, n = (item >> 1) & 7, gc = item >> 4;
  const int T = stream ? 1024 : 256;
  const int seq = stream ? (gc >> 4) : (gc >> 2), cidx = stream ? (gc & 15) : (gc & 3);
  const bf16_t* P = (const bf16_t*)(p.WS() + W_P);
  const size_t tokbase = (size_t)seq * T;
  const int ch0 = n * 64 + 4 * fr;
  const bf16_t* wg = (const bf16_t*)(p.WS() + W_WG) + (size_t)((l * 2 + dir) * 8 + n) * 128 * 64;
  bf16x8 wfa[4][2], wfx[4][2];
#pragma unroll
  for (int nb = 0; nb < 4; ++nb)
#pragma unroll
    for (int ks = 0; ks < 2; ++ks) {
      wfa[nb][ks] = *(const bf16x8*)(wg + (4 * fr + nb) * 64 + ks * 32 + quad * 8);
      wfx[nb][ks] = *(const bf16x8*)(wg + (64 + 4 * fr + nb) * 64 + ks * 32 + quad * 8);
    }
  float cb[4], ba[4], bx[4], sp2[4], H[4], AP[4];
  const float* cwp = p.IN(19) + (size_t)l * 4 * 512 + ch0;
  {
    const float4 c4 = *(const float4*)(p.IN(20) + l * 512 + ch0); cb[0] = c4.x; cb[1] = c4.y; cb[2] = c4.z; cb[3] = c4.w;
    const float4 a4 = *(const float4*)(p.IN(22) + (l * 2 + dir) * 512 + ch0); ba[0] = a4.x; ba[1] = a4.y; ba[2] = a4.z; ba[3] = a4.w;
    const float4 x4 = *(const float4*)(p.IN(24) + (l * 2 + dir) * 512 + ch0); bx[0] = x4.x; bx[1] = x4.y; bx[2] = x4.z; bx[3] = x4.w;
    const float4 l4 = *(const float4*)(p.IN(25) + (l * 2 + dir) * 512 + ch0);
    const float lm[4] = {l4.x, l4.y, l4.z, l4.w};
#pragma unroll
    for (int nb = 0; nb < 4; ++nb) { sp2[nb] = 8.f * LOG2E * logf(1.f + expf(-lm[nb])); H[nb] = 0.f; AP[nb] = 1.f; }
  }
  bf16_t* LOC = (bf16_t*)(p.WS() + W_HF) + (size_t)dir * NTOK * 512;
  bf16_t* APR = (bf16_t*)(p.WS() + W_H) + (size_t)dir * NTOK * 512;
  const int tc0 = cidx * 64;
  uint2 cxn[7];
  lru_load(P, tokbase, T, tc0 + (dir ? 3 : 0) * 16, quad, ch0, cxn);
  for (int step = 0; step < 4; ++step) {
    const int t0 = tc0 + (dir ? (3 - step) : step) * 16;
    uint2 cxr[7];
#pragma unroll
    for (int rr = 0; rr < 7; ++rr) cxr[rr] = cxn[rr];
    if (step + 1 < 4) lru_load(P, tokbase, T, tc0 + (dir ? (2 - step) : step + 1) * 16, quad, ch0, cxn);
    float cw[4][4];
#pragma unroll
    for (int j = 0; j < 4; ++j) { const float4 t4 = *(const float4*)(cwp + j * 512); cw[j][0] = t4.x; cw[j][1] = t4.y; cw[j][2] = t4.z; cw[j][3] = t4.w; }
    float xc[4][4];
#pragma unroll
    for (int i = 0; i < 4; ++i)
#pragma unroll
      for (int nb = 0; nb < 4; ++nb) {
        float s = cb[nb];
#pragma unroll
        for (int j = 0; j < 4; ++j) {
          const unsigned w = (nb < 2) ? cxr[i + j].x : cxr[i + j].y;
          const float cv = (nb & 1) ? __uint_as_float(w & 0xffff0000u) : __uint_as_float(w << 16);
          s += cv * cw[j][nb];
        }
        xc[i][nb] = s;
      }
    __builtin_amdgcn_wave_barrier();
#pragma unroll
    for (int i = 0; i < 4; ++i) { uint2 v; v.x = pk_bf16(xc[i][0], xc[i][1]); v.y = pk_bf16(xc[i][2], xc[i][3]); *(uint2*)(wl + (4 * quad + i) * 128 + fr * 8) = v; }
    __builtin_amdgcn_fence(__ATOMIC_RELEASE, "wavefront");
    __builtin_amdgcn_wave_barrier();
    __builtin_amdgcn_fence(__ATOMIC_ACQUIRE, "wavefront");
    bf16x8 af[2];
#pragma unroll
    for (int ks = 0; ks < 2; ++ks) af[ks] = *(const bf16x8*)(wl + fr * 128 + ks * 64 + quad * 16);
    __builtin_amdgcn_wave_barrier();
    float hv[4][4], av[4][4];
#pragma unroll
    for (int nb = 0; nb < 4; ++nb) {
      f32x4 ga = mfma16(af[0], wfa[nb][0], (f32x4){0.f, 0.f, 0.f, 0.f}); ga = mfma16(af[1], wfa[nb][1], ga);
      f32x4 gx = mfma16(af[0], wfx[nb][0], (f32x4){0.f, 0.f, 0.f, 0.f}); gx = mfma16(af[1], wfx[nb][1], gx);
      float a[4], u[4];
#pragma unroll
      for (int i = 0; i < 4; ++i) {
        const float r = sigm(ga[i] + ba[nb]), ig = sigm(gx[i] + bx[nb]);
        a[i] = ex2(-sp2[nb] * r);
        u[i] = sqrtf(fmaxf(0.f, 1.f - a[i] * a[i])) * ig * xc[i][nb];
      }
      float Ls[4], Pas[4], L = 0.f, Pa = 1.f;
#pragma unroll
      for (int ii = 0; ii < 4; ++ii) { const int i = dir ? 3 - ii : ii; L = a[i] * L + u[i]; Pa *= a[i]; Ls[i] = L; Pas[i] = Pa; }
      float c = H[nb], ap = AP[nb], cq = 0.f, aq = 1.f;
      float paq[4], luq[4];
      quad_gather(Pa, paq); quad_gather(L, luq);
#pragma unroll
      for (int qq = 0; qq < 4; ++qq) {
        const int q = dir ? 3 - qq : qq;
        const float pa_q = paq[q], lu_q = luq[q];
        if (q == quad) { cq = c; aq = ap; }
        c = pa_q * c + lu_q; ap *= pa_q;
      }
      H[nb] = c; AP[nb] = ap;
#pragma unroll
      for (int i = 0; i < 4; ++i) { hv[i][nb] = Ls[i] + Pas[i] * cq; av[i][nb] = Pas[i] * aq; }
    }
#pragma unroll
    for (int i = 0; i < 4; ++i) {
      const size_t e = (tokbase + t0 + 4 * quad + i) * 512 + ch0;
      store_bf16x4(LOC + e, hv[i][0], hv[i][1], hv[i][2], hv[i][3]);
      store_bf16x4(APR + e, av[i][0], av[i][1], av[i][2], av[i][3]);
    }
  }
  if (quad == 0) {
    float* sm = (float*)(p.WS() + W_MODP) + ((size_t)(gc * 8 + n) * 2 + dir) * 128 + 4 * fr;
    *(float4*)sm = make_float4(AP[0], AP[1], AP[2], AP[3]);
    *(float4*)(sm + 64) = make_float4(H[0], H[1], H[2], H[3]);
  }
}

DEV void lru_fix(const PV& p, int stream, int l, int item, int fr, int quad) {
  const int n = item & 7, gc = item >> 3;
  const int nck = stream ? 16 : 4;
  const int seq = stream ? (gc >> 4) : (gc >> 2), cidx = stream ? (gc & 15) : (gc & 3);
  const int ch0 = n * 64 + 4 * fr;
  const float* sm = (const float*)(p.WS() + W_MODP);
  float hf[4] = {0.f, 0.f, 0.f, 0.f}, hb[4] = {0.f, 0.f, 0.f, 0.f};
  if (stream) {
    const float4 f4 = *(const float4*)(p.IN(6) + ((size_t)(seq * 2 + l) * 2 + 0) * 512 + ch0);
    const float4 b4 = *(const float4*)(p.IN(6) + ((size_t)(seq * 2 + l) * 2 + 1) * 512 + ch0);
    hf[0] = f4.x; hf[1] = f4.y; hf[2] = f4.z; hf[3] = f4.w; hb[0] = b4.x; hb[1] = b4.y; hb[2] = b4.z; hb[3] = b4.w;
  }
  const int g0 = gc - cidx;
  for (int c = 0; c < cidx; ++c) {
    const float* s0 = sm + ((size_t)((g0 + c) * 8 + n) * 2 + 0) * 128 + 4 * fr;
    const float4 pa = *(const float4*)s0, lu = *(const float4*)(s0 + 64);
    hf[0] = pa.x * hf[0] + lu.x; hf[1] = pa.y * hf[1] + lu.y; hf[2] = pa.z * hf[2] + lu.z; hf[3] = pa.w * hf[3] + lu.w;
  }
  for (int c = nck - 1; c > cidx; --c) {
    const float* s1 = sm + ((size_t)((g0 + c) * 8 + n) * 2 + 1) * 128 + 4 * fr;
    const float4 pa = *(const float4*)s1, lu = *(const float4*)(s1 + 64);
    hb[0] = pa.x * hb[0] + lu.x; hb[1] = pa.y * hb[1] + lu.y; hb[2] = pa.z * hb[2] + lu.z; hb[3] = pa.w * hb[3] + lu.w;
  }
  if (!stream && quad == 0) {
    if (cidx == nck - 1) {
      const float* s0 = sm + ((size_t)(gc * 8 + n) * 2 + 0) * 128 + 4 * fr;
      const float4 pa = *(const float4*)s0, lu = *(const float4*)(s0 + 64);
      *(float4*)(p.OUT() + O_LRU + ((size_t)(seq * 2 + l) * 2 + 0) * 512 + ch0) = make_float4(pa.x * hf[0] + lu.x, pa.y * hf[1] + lu.y, pa.z * hf[2] + lu.z, pa.w * hf[3] + lu.w);
    }
    if (cidx == 0) {
      const float* s1 = sm + ((size_t)(gc * 8 + n) * 2 + 1) * 128 + 4 * fr;
      const float4 pa = *(const float4*)s1, lu = *(const float4*)(s1 + 64);
      *(float4*)(p.OUT() + O_LRU + ((size_t)(seq * 2 + l) * 2 + 1) * 512 + ch0) = make_float4(pa.x * hb[0] + lu.x, pa.y * hb[1] + lu.y, pa.z * hb[2] + lu.z, pa.w * hb[3] + lu.w);
    }
  }
  const bf16_t* P = (const bf16_t*)(p.WS() + W_P);
  bf16_t* LOC = (bf16_t*)(p.WS() + W_HF);
  const bf16_t* APR = (const bf16_t*)(p.WS() + W_H);
#pragma unroll 4
  for (int k = 0; k < 16; ++k) {
    const size_t tok = (size_t)gc * 64 + k * 4 + quad;
    const size_t e = tok * 512 + ch0;
    const uint2 lf = *(const uint2*)(LOC + e), lb = *(const uint2*)(LOC + (size_t)NTOK * 512 + e);
    const uint2 af = *(const uint2*)(APR + e), ab = *(const uint2*)(APR + (size_t)NTOK * 512 + e);
    const uint2 cg = *(const uint2*)(P + tok * NCOL + C_CG + ch0);
    float y[4];
#pragma unroll
    for (int q = 0; q < 4; ++q) {
      const unsigned wlf = (q < 2) ? lf.x : lf.y, wlb = (q < 2) ? lb.x : lb.y, waf = (q < 2) ? af.x : af.y, wab = (q < 2) ? ab.x : ab.y, wcg = (q < 2) ? cg.x : cg.y;
      const float vlf = (q & 1) ? __uint_as_float(wlf & 0xffff0000u) : __uint_as_float(wlf << 16);
      const float vlb = (q & 1) ? __uint_as_float(wlb & 0xffff0000u) : __uint_as_float(wlb << 16);
      const float vaf = (q & 1) ? __uint_as_float(waf & 0xffff0000u) : __uint_as_float(waf << 16);
      const float vab = (q & 1) ? __uint_as_float(wab & 0xffff0000u) : __uint_as_float(wab << 16);
      const float vcg = (q & 1) ? __uint_as_float(wcg & 0xffff0000u) : __uint_as_float(wcg << 16);
      y[q] = ((vlf + vaf * hf[q]) + (vlb + vab * hb[q])) * vcg;
    }
    store_bf16x4(LOC + e, y[0], y[1], y[2], y[3]);
  }
}

DEV void phase_lru(const PV& p, int stream, int l, unsigned char* smem) {
  const int tix = ltid(); const int lane = tix & 63, wv = tix >> 6, fr = lane & 15, quad = lane >> 4;
  unsigned char* wl = smem + AT_LRU + wv * 2048;
  for (int it = blockIdx.x * 8 + wv; it < 2048; it += gridDim.x * 8) lru_item(p, stream, l, it, wl, lane, fr, quad);
}

DEV void phase_mixers(const PV& p, int stream, int l, unsigned char* smem) {
  const int tix = ltid(); const int lane = tix & 63, wv = tix >> 6, fr = lane & 15, quad = lane >> 4;
  int* ctrs = (int*)(p.WS() + W_CTR);
  int* workctr = ctrs + (stream * 2 + l);
  volatile int* qw = (volatile int*)(smem + AT_MISC);
  const int n_fix = 128;
  const int total = n_fix + (stream ? (256 + 512) : 512);
  auto next = [&]() { __syncthreads(); if (tix == 0) *qw = atomicAdd(workctr, 1); __syncthreads(); int v = *qw; asm volatile("" : "+v"(v)); return v; };
  int it = next();
  while (it < n_fix) { lru_fix(p, stream, l, it * 8 + wv, fr, quad); it = next(); }
  if (!stream) {
    while (it < total) { attn_ctx_item(p, l, it - n_fix, smem, tix, wv, fr, quad); it = next(); }
  } else {
    while (it < n_fix + 256) { attn_latA_item(p, l, it - n_fix, smem, tix, wv, fr, quad); it = next(); }
    while (it < total) { attn_latB_item(p, l, it - n_fix - 256, smem, tix, wv, fr, quad); it = next(); }
  }
}

DEV void phase_merge(const PV& p, int l, unsigned char* smem) {
  const int tix = ltid(); const int lane = tix & 63, wv = tix >> 6, wr = wv >> 1, wc = wv & 1, fr = lane & 15, quad = lane >> 4;
  const bf16_t* P = (const bf16_t*)(p.WS() + W_P);
  bf16_t* Z = (bf16_t*)(p.WS() + W_HB);
  const bf16_t* YF = (const bf16_t*)(p.WS() + W_HF);
  for (int t = blockIdx.x; t < 256; t += gridDim.x) {
    const int xcd = t & 7, j = t >> 3, pm = xcd * 4 + (j & 3), pn = j >> 2;
    f32x4 z[4][4];
#pragma unroll
    for (int m = 0; m < 4; ++m)
#pragma unroll
      for (int n = 0; n < 4; ++n) z[m][n] = (f32x4){0.f, 0.f, 0.f, 0.f};
    f32x4 acc[4][4];
#pragma unroll 1
    for (int i = 0; i < 3; ++i) {
      const int br = i;
      const bf16_t* Ap; int lda;
      if (i < 2) { Ap = (const bf16_t*)(p.WS() + W_Y) + (size_t)pm * 256 * 1024 + i * 512; lda = 1024; }
      else { Ap = YF + (size_t)pm * 256 * 512; lda = 512; }
      const bf16_t* Wb = (const bf16_t*)(p.WS() + W_WT_BR) + ((size_t)(l * 3 + br) * 1024 + pn * 128) * 512;
#pragma unroll
      for (int m = 0; m < 4; ++m)
#pragma unroll
        for (int n = 0; n < 4; ++n) acc[m][n] = (f32x4){0.f, 0.f, 0.f, 0.f};
      gemm_kloop(Ap, lda, Wb, 512, 512, smem, acc, wr, wc, fr, quad, tix);
      {
        const bf16_t* G = P + (size_t)(pm * 256) * NCOL + C_MG + br * 1024 + pn * 128;
        const bf16_t* gp = G + (size_t)(tix >> 4) * NCOL + (((tix & 15) ^ ((tix >> 4) & 15)) * 8);
        unsigned char* lp = smem + tix * 16;
#pragma unroll
        for (int k = 0; k < 8; ++k) {
          __builtin_amdgcn_global_load_lds((const void*)gp, (LAS void*)lp, 16, 0, 0);
          gp += 32 * NCOL; lp += 8192;
        }
        asm volatile("s_waitcnt vmcnt(0)" ::: "memory");
        __syncthreads();
#pragma unroll
        for (int m = 0; m < 4; ++m)
#pragma unroll
          for (int n = 0; n < 4; ++n) {
            const int row = wr * 64 + m * 16 + fr, colb = (wc * 64 + n * 16 + 4 * quad) * 2;
            const bf16x4 g = *(const bf16x4*)(smem + row * 256 + (((colb >> 4) ^ (row & 15)) << 4) + (colb & 15));
#pragma unroll
            for (int e = 0; e < 4; ++e) z[m][n][e] += acc[m][n][e] * bf2f((unsigned short)g[e]);
          }
      }
    }
#pragma unroll
    for (int m = 0; m < 4; ++m)
#pragma unroll
      for (int n = 0; n < 4; ++n) {
        const int row = pm * 256 + wr * 64 + m * 16 + fr, col = pn * 128 + wc * 64 + n * 16 + 4 * quad;
        store_bf16x4(Z + (size_t)row * 1024 + col, z[m][n][0], z[m][n][1], z[m][n][2], z[m][n][3]);
      }
  }
}

DEV void phase_out(const PV& p, int stream, int l, unsigned char* smem) {
  const int tix = ltid(); const int lane = tix & 63, wv = tix >> 6, wr = wv >> 1, wc = wv & 1, fr = lane & 15, quad = lane >> 4;
  const bf16_t* Z = (const bf16_t*)(p.WS() + W_HB);
  const float* xin = (l == 0) ? p.IN(stream) : (p.OUT() + (size_t)stream * 8388608);
  float* yout = p.OUT() + (size_t)stream * 8388608;
  const float* mod = (const float*)(p.WS() + W_MOD);
  for (int t = blockIdx.x; t < 256; t += gridDim.x) {
    const int xcd = t & 7, j = t >> 3, pm = xcd * 4 + (j & 3), pn = j >> 2;
    f32x4 acc[4][4];
#pragma unroll
    for (int m = 0; m < 4; ++m)
#pragma unroll
      for (int n = 0; n < 4; ++n) acc[m][n] = (f32x4){0.f, 0.f, 0.f, 0.f};
    gemm_kloop(Z + (size_t)pm * 256 * 1024, 1024, (const bf16_t*)(p.WS() + W_WT_OUT) + ((size_t)l * 1024 + pn * 128) * 1024, 1024, 1024, smem, acc, wr, wc, fr, quad, tix);
#pragma unroll
    for (int m = 0; m < 4; ++m)
#pragma unroll
      for (int n = 0; n < 4; ++n) {
        const int row = pm * 256 + wr * 64 + m * 16 + fr, col = pn * 128 + wc * 64 + n * 16 + 4 * quad;
        const int jj = stream ? 1 + (row >> 10) : 0;
        const float4 gt = *(const float4*)(mod + (size_t)(l * 9 + jj) * 3072 + 2048 + col);
        const float4 xv = *(const float4*)(xin + (size_t)row * 1024 + col);
        *(float4*)(yout + (size_t)row * 1024 + col) = make_float4(xv.x + gt.x * acc[m][n][0], xv.y + gt.y * acc[m][n][1], xv.z + gt.z * acc[m][n][2], xv.w + gt.w * acc[m][n][3]);
      }
  }
}

__global__ void __launch_bounds__(512) mega(Params pp, int ph_lo, int ph_hi) {
  extern __shared__ __attribute__((aligned(16))) unsigned char smem[];
  cg::grid_group grid = cg::this_grid();
  volatile LAS unsigned* xst = (volatile LAS unsigned*)(smem + LDS_GEMM);
  if (threadIdx.x == 0) { xst[0] = 0u; xst[1] = 0u; xst[2] = 0u; xst[3] = 0u; }
  __syncthreads();
  XcdBarrier xb = xcd_barrier_post((unsigned*)(pp.ws + W_BAR), xst);
  for (int ph = ph_lo; ph <= ph_hi; ++ph) {
    if (ph == 1) continue;
    if (ph == 2 + 2 * 6) continue;
    if (ph > ph_lo) { if (ph_hi < 0) grid.sync(); xcd_barrier(xb); }
    PV p; p.pp = &pp;
    asm volatile("s_mov_b64 %0, 0" : "=s"(p.zs));
    {
      __attribute__((address_space(1))) unsigned char* gws = (__attribute__((address_space(1))) unsigned char*)pp.ws;
      __attribute__((address_space(1))) float* gout = (__attribute__((address_space(1))) float*)pp.out;
      asm volatile("" : "+s"(gws), "+s"(gout));
      p.ws = (unsigned char*)gws; p.out = (float*)gout;
    }
#ifndef PHM
#define PHM 127
#endif
    if (ph == 0) { if (PHM & 1) phase_prep(p, smem);
#ifdef DUP_PREP
      grid.sync(); phase_prep(p, smem);
#endif
    }
    else if (ph == 1) { if (PHM & 1) phase_modfin(p); }
    else {
      const int si = (ph - 2) / 6, sub = (ph - 2) % 6, stream = si >> 1, l = si & 1;
      if (sub == 0) phase_norm(p, stream, l);
      else if (sub == 1) phase_inproj(p, stream, l, smem);
      else if (sub == 2) phase_lru(p, stream, l, smem);
      else if (sub == 3) phase_mixers(p, stream, l, smem);
      else if (sub == 4) phase_merge(p, l, smem);
      else { phase_out(p, stream, l, smem); if (si == 1) phase_norm(p, 1, 0); }
    }
  }
}

extern "C" void kernel_launch(void* const* d_in, const int* in_sizes, int n_in, void* d_out, int out_size, void* d_ws, size_t ws_size, hipStream_t stream) {
  Params p{};
  for (int i = 0; i < 28; ++i) p.in[i] = (const float*)d_in[i];
  p.out = (float*)d_out;
  p.ws = (unsigned char*)d_ws;
  static int grid_blocks = 0;
  if (!grid_blocks) {
    hipFuncSetAttribute((const void*)mega, hipFuncAttributeMaxDynamicSharedMemorySize, LDS_BYTES);
    int dev = 0, cus = 0, per_cu = 0;
    hipGetDevice(&dev);
    hipDeviceGetAttribute(&cus, hipDeviceAttributeMultiprocessorCount, dev);
    hipOccupancyMaxActiveBlocksPerMultiprocessor(&per_cu, mega, 512, LDS_BYTES);
    if (per_cu < 1) per_cu = 1;
    grid_blocks = cus;
    if (ws_size < W_END) fprintf(stderr, "workspace too small: %zu < %zu\n", ws_size, (size_t)W_END);
  }
  hipMemsetAsync((unsigned char*)d_ws + W_BAR, 0, XCD_BAR_WORDS * 4, stream);
#if ONE_LAUNCH
  int lo = 0, hi = NPHASE - 1;
  void* args[] = {&p, &lo, &hi};
  hipError_t e = hipLaunchCooperativeKernel((const void*)mega, dim3(grid_blocks), dim3(512), args, LDS_BYTES, stream);
  if (e != hipSuccess) fprintf(stderr, "cooperative launch failed: %s (grid %d)\n", hipGetErrorString(e), grid_blocks);
#else
  for (int ph = 0; ph < NPHASE; ++ph) hipLaunchKernelGGL(mega, dim3(grid_blocks), dim3(512), LDS_BYTES, stream, p, ph, ph);
#endif
}
```

```cpp
#include <hip/hip_runtime.h>
#include <hip/hip_cooperative_groups.h>
#include <cstdio>
namespace cg = cooperative_groups;

#define ATTN_SIMPLE 1
#ifndef ONE_LAUNCH
#define ONE_LAUNCH 1
#endif

typedef unsigned short bf16_t;
typedef short bf16x8 __attribute__((ext_vector_type(8)));
typedef short bf16x4 __attribute__((ext_vector_type(4)));
typedef float f32x4 __attribute__((ext_vector_type(4)));
#define DEV __device__ __forceinline__
#define LAS __attribute__((address_space(3)))

constexpr int DM = 1024, NCOL = 7424, NTOK = 8192;
constexpr float LOG2E = 1.4426950408889634f;
constexpr size_t O_Y = 0, O_KA = 16777216, O_VA = 18874368, O_KB = 20971520, O_VB = 29360128, O_LRU = 37748736;
constexpr int C_AQ = 0, C_AK = 512, C_AG = 768, C_BQ = 1280, C_BK = 1792, C_BG = 2816, C_CX = 3328, C_CG = 3840, C_MG = 4352;
constexpr size_t W_WT_IN = 0;
constexpr size_t W_WT_BR = W_WT_IN + (size_t)2 * NCOL * 1024 * 2;
constexpr size_t W_WT_OUT = W_WT_BR + (size_t)6 * 1024 * 512 * 2;
constexpr size_t W_WG = W_WT_OUT + (size_t)2 * 1024 * 1024 * 2;
constexpr size_t W_CKA = W_WG + (size_t)32 * 128 * 64 * 2;
constexpr size_t W_CVAT = W_CKA + (size_t)16 * 512 * 128 * 2;
constexpr size_t W_CKB = W_CVAT + (size_t)16 * 128 * 512 * 2;
constexpr size_t W_CVBT = W_CKB + (size_t)16 * 512 * 512 * 2;
constexpr int KS_ADA = 16;
constexpr size_t W_MODP = W_CVBT + (size_t)16 * 512 * 512 * 2;
constexpr size_t W_MOD = W_MODP + (size_t)KS_ADA * 2 * 9 * 3072 * 4;
constexpr size_t W_ROPE = W_MOD + (size_t)2 * 9 * 3072 * 4;
constexpr size_t W_CTR = W_ROPE + 8192;
constexpr size_t W_H = W_CTR + 8192;
constexpr size_t W_P = W_H + (size_t)NTOK * 1024 * 2;
constexpr size_t W_VAT = W_P + (size_t)NTOK * NCOL * 2;
constexpr size_t W_VBT = W_VAT + (size_t)NTOK * 128 * 2;
constexpr size_t W_HF = W_VBT + (size_t)NTOK * 512 * 2;
constexpr size_t W_HB = W_HF + (size_t)NTOK * 512 * 4;
constexpr size_t W_Y = W_HB + (size_t)NTOK * 512 * 4;
constexpr size_t W_BAR = W_Y + (size_t)NTOK * 1024 * 2;
constexpr size_t W_END = W_BAR + 16384;
static_assert(W_END <= (size_t)256 * 1024 * 1024, "workspace too large");

constexpr int GA_BYTES = 256 * 64 * 2, GB_BYTES = 128 * 64 * 2, GSTAGE = GA_BYTES + GB_BYTES;
constexpr int LDS_GEMM = 3 * GSTAGE;
constexpr int LDS_BYTES = LDS_GEMM + 16;
constexpr int EP_LD = 132;
constexpr int NPHASE = 26;

struct Params {
  const float* in[28];
  float* out;
  unsigned char* ws;
};
struct PV {
  const Params* pp; long zs; unsigned char* ws; float* out;
  DEV const float* IN(int i) const { return (const float*)((const char*)pp->in[i] + zs); }
  DEV float* OUT() const { return out; }
  DEV unsigned char* WS() const { return ws; }
};

DEV int ltid() { int t = threadIdx.x; asm volatile("" : "+v"(t)); return t; }
DEV float bf2f(unsigned short b) { return __uint_as_float(((unsigned)b) << 16); }
typedef __bf16 bf16v2_t __attribute__((ext_vector_type(2)));
typedef float f32v2_t __attribute__((ext_vector_type(2)));
DEV unsigned pk_bf16(float lo, float hi) { f32v2_t f = {lo, hi}; bf16v2_t b = __builtin_convertvector(f, bf16v2_t); return __builtin_bit_cast(unsigned, b); }
DEV float ex2(float x) { return __builtin_amdgcn_exp2f(x); }
DEV float sigm(float x) { return __builtin_amdgcn_rcpf(1.f + ex2(-x * LOG2E)); }
DEV f32x4 mfma16(bf16x8 a, bf16x8 b, f32x4 c) { return __builtin_amdgcn_mfma_f32_16x16x32_bf16(a, b, c, 0, 0, 0); }
DEV void quad_gather(float x, float (&q)[4]) {
  const unsigned xi = __float_as_uint(x);
  const auto r = __builtin_amdgcn_permlane16_swap(xi, xi, false, false);
  const auto e = __builtin_amdgcn_permlane32_swap(r[0], r[0], false, false);
  const auto o = __builtin_amdgcn_permlane32_swap(r[1], r[1], false, false);
  q[0] = __uint_as_float(e[0]); q[1] = __uint_as_float(o[0]); q[2] = __uint_as_float(e[1]); q[3] = __uint_as_float(o[1]);
}
DEV float quad_max(float x) { float q[4]; quad_gather(x, q); return fmaxf(fmaxf(q[0], q[1]), fmaxf(q[2], q[3])); }
DEV void store_bf16x4(bf16_t* p, float a, float b, float c, float d) { uint2 v; v.x = pk_bf16(a, b); v.y = pk_bf16(c, d); *(uint2*)p = v; }


#define XB_TMO      128
#define XB_XCNT(j)  (256  + 64 * (j))
#define XB_XSUB(j)  (1280 + 64 * (j))
#define XB_XGEN(j)  (2304 + 64 * (j))
#define XB_TOP      3328
#define XB_TOPGEN   3392
#define XCD_BAR_WORDS 3456
#define XB_SPIN_CAP (1u << 18)
DEV unsigned xb_ld(unsigned* p) { return __hip_atomic_load(p, __ATOMIC_RELAXED, __HIP_MEMORY_SCOPE_AGENT); }
DEV unsigned xb_add(unsigned* p, unsigned v) { return __hip_atomic_fetch_add(p, v, __ATOMIC_RELAXED, __HIP_MEMORY_SCOPE_AGENT); }
DEV unsigned xb_xcc_id() { return (unsigned)__builtin_amdgcn_s_getreg((3 << 11) | 20) & 0xFu; }
#define XB_SPIN(cond, bar) do { unsigned _sp = 0; while (cond) { \
    if ((++_sp & 255u) == 0u) { if (xb_ld(&(bar)[XB_TMO])) break; if (_sp > XB_SPIN_CAP) { atomicAdd(&(bar)[XB_TMO], 1u); break; } } } } while (0)
struct XcdBarrier { unsigned* bar; unsigned x; volatile LAS unsigned* st; };
DEV XcdBarrier xcd_barrier_post(unsigned* bar, volatile LAS unsigned* st) {
  XcdBarrier b; b.bar = bar; b.x = xb_xcc_id(); b.st = st;
  if (threadIdx.x == 0) (void)xb_add(&bar[XB_XCNT(b.x)], 1u);
  return b;
}
DEV void xcd_barrier_complete(unsigned* bar, unsigned x, unsigned& nloc, unsigned& nx) {
  const unsigned G = gridDim.x * gridDim.y * gridDim.z;
  unsigned sum, cnt, mine, sp = 0u;
  for (;;) {
    sum = 0u; cnt = 0u; mine = 0u;
#pragma unroll
    for (unsigned j = 0; j < 16; ++j) { const unsigned c = xb_ld(&bar[XB_XCNT(j)]); sum += c; cnt += (c > 0u) ? 1u : 0u; mine = (j == x) ? c : mine; }
    if (sum == G) break;
    __builtin_amdgcn_s_sleep(1);
    if ((++sp & 255u) == 0u) { if (xb_ld(&bar[XB_TMO])) break; if (sp > XB_SPIN_CAP) { atomicAdd(&bar[XB_TMO], 1u); break; } }
  }
  nloc = mine > 0u ? mine : 1u; nx = cnt > 0u ? cnt : 1u;
}
DEV void xcd_barrier(const XcdBarrier& b) {
  asm volatile("s_waitcnt vmcnt(0)" ::: "memory");
  __syncthreads();
  if (threadIdx.x == 0) {
    unsigned* bar = b.bar;
    asm volatile("" : "+s"(bar));
    __builtin_amdgcn_s_waitcnt(0);
    unsigned nloc = b.st[0], nx = b.st[1];
    if (nloc == 0u) { xcd_barrier_complete(bar, b.x, nloc, nx); b.st[0] = nloc; b.st[1] = nx; }
    const unsigned old = xb_add(&bar[XB_XSUB(b.x)], 1u);
    const unsigned gen = old / nloc;
    if (old + 1u == (gen + 1u) * nloc) {
      __builtin_amdgcn_fence(__ATOMIC_RELEASE, "agent");
      asm volatile("s_waitcnt vmcnt(0)" ::: "memory");
      const unsigned og = xb_add(&bar[XB_TOP], 1u);
      const unsigned tg = og / nx;
      if (og + 1u == (tg + 1u) * nx) xb_add(&bar[XB_TOPGEN], 1u);
      else XB_SPIN(xb_ld(&bar[XB_TOPGEN]) == tg, bar);
      __builtin_amdgcn_fence(__ATOMIC_ACQUIRE, "agent");
      xb_add(&bar[XB_XGEN(b.x)], 1u);
      asm volatile("s_waitcnt vmcnt(0)" ::: "memory");
    } else {
      XB_SPIN(xb_ld(&bar[XB_XGEN(b.x)]) == gen, bar);
      __builtin_amdgcn_fence(__ATOMIC_ACQUIRE, "agent");
      asm volatile("s_waitcnt vmcnt(0)" ::: "memory");
    }
  }
  __syncthreads();
}

DEV void transpose_tile(const float* __restrict__ src, int sld, bf16_t* __restrict__ dst, int dld, float* lds, int tid) {
  {
    const int c = tid & 63, r0 = tid >> 6;
#pragma unroll
    for (int k = 0; k < 8; ++k) { const int r = r0 + 8 * k; lds[r * 65 + c] = src[(size_t)r * sld + c]; }
  }
  __syncthreads();
  {
    const int r2 = (tid & 31) * 2, c0 = tid >> 5;
#pragma unroll
    for (int k = 0; k < 4; ++k) {
      const int c = c0 + 16 * k;
      *(unsigned*)(dst + (size_t)c * dld + r2) = pk_bf16(lds[r2 * 65 + c], lds[(r2 + 1) * 65 + c]);
    }
  }
  __syncthreads();
}

DEV void transpose_wide(const float* __restrict__ src, int sld, bf16_t* __restrict__ dst, int dld, float* lds, int tid) {
  {
    const int c4 = tid & 63, r0 = tid >> 6;
#pragma unroll 4
    for (int k = 0; k < 8; ++k) {
      const int r = r0 + 8 * k;
      const float4 v = *(const float4*)(src + (size_t)r * sld + c4 * 4);
      float* d = lds + r * 257 + c4 * 4;
      d[0] = v.x; d[1] = v.y; d[2] = v.z; d[3] = v.w;
    }
  }
  __syncthreads();
  {
    const int r2 = (tid & 31) * 2, c0 = tid >> 5;
    const size_t cs = (dld < 0) ? 32 : (size_t)dld;
    bf16_t* dp = (dld < 0) ? dst + (size_t)(r2 >> 5) * 8192 + (r2 & 31) : dst + r2;
#pragma unroll 4
    for (int k = 0; k < 16; ++k) {
      const int c = c0 + 16 * k;
      *(unsigned*)(dp + (size_t)c * cs) = pk_bf16(lds[r2 * 257 + c], lds[(r2 + 1) * 257 + c]);
    }
  }
  __syncthreads();
}
DEV void tpw_mat(const float* src, int R, int C, bf16_t* dst, int dld, int idx, float* lds, int tid) {
  const int ntc = C >> 8, tr = idx / ntc, tc = idx % ntc;
  if (dld < 0) transpose_wide(src + (size_t)tr * 64 * C + tc * 256, C, dst + (size_t)tc * 262144 + (size_t)tr * 2 * 8192, dld, lds, tid);
  else transpose_wide(src + (size_t)tr * 64 * C + tc * 256, C, dst + (size_t)tc * 256 * dld + tr * 64, dld, lds, tid);
}
DEV void tp_mat(const float* src, int R, int C, bf16_t* dst, int dld, int idx, float* lds, int tid) {
  const int ntc = C >> 6, tr = idx / ntc, tc = idx % ntc;
  transpose_tile(src + (size_t)tr * 64 * C + tc * 64, C, dst + (size_t)tc * 64 * dld + tr * 64, dld, lds, tid);
}

DEV void phase_prep(const PV& p, unsigned char* smem) {
  float* lds = (float*)smem;
  const int tid = ltid();
  constexpr int N_ADA = 2 * KS_ADA * 6;
  constexpr int N_TP = 928 + 192 + 128 + 64 + 256 + 256;
  constexpr int N_CV = 256 + 1024;
  constexpr int N_ALL = N_ADA + N_TP + N_CV + 1;
  for (int it = blockIdx.x; it < N_ALL; it += gridDim.x) {
    if (it < N_ADA) {
      const int l = it / (KS_ADA * 6), ks = (it / 6) % KS_ADA, cc = it % 6;
      const int kc = 1024 / KS_ADA;
      __syncthreads();
      for (int e = tid; e < 9 * kc; e += 512) {
        const int j = e / kc, kk = e % kc, k = ks * kc + kk;
        const float cv = (j == 0) ? p.IN(8)[k] : p.IN(7)[(j - 1) * 1024 + k];
        lds[e] = cv * sigm(cv);
      }
      __syncthreads();
      const int col = cc * 512 + tid;
      const float* W = p.IN(10) + (size_t)l * 1024 * 3072 + (size_t)ks * kc * 3072 + col;
      float acc[9];
#pragma unroll
      for (int j = 0; j < 9; ++j) acc[j] = 0.f;
#pragma unroll 8
      for (int kk = 0; kk < kc; ++kk) {
        const float w = W[(size_t)kk * 3072];
#pragma unroll
        for (int j = 0; j < 9; ++j) acc[j] += lds[j * kc + kk] * w;
      }
      float* mp = (float*)(p.WS() + W_MODP);
#pragma unroll
      for (int j = 0; j < 9; ++j) mp[((size_t)(ks * 2 + l) * 9 + j) * 3072 + col] = acc[j];
      __syncthreads();
    } else if (it < N_ADA + N_TP) {
      int x = it - N_ADA;
      if (x < 928) { const int m = x / 464; tpw_mat(p.IN(12) + (size_t)m * 1024 * NCOL, 1024, NCOL, (bf16_t*)(p.WS() + W_WT_IN) + (size_t)m * NCOL * 1024, -1, x % 464, lds, tid); continue; }
      x -= 928;
      if (x < 192) { const int m = x / 32; tpw_mat(p.IN(26) + (size_t)m * 512 * 1024, 512, 1024, (bf16_t*)(p.WS() + W_WT_BR) + (size_t)m * 1024 * 512, 512, x % 32, lds, tid); continue; }
      x -= 192;
      if (x < 128) { const int m = x / 64; tpw_mat(p.IN(27) + (size_t)m * 1024 * 1024, 1024, 1024, (bf16_t*)(p.WS() + W_WT_OUT) + (size_t)m * 1024 * 1024, 1024, x % 64, lds, tid); continue; }
      x -= 128;
      if (x < 64) { const int which = x >> 5, m = x & 31;
        tp_mat(p.IN(which ? 23 : 21) + (size_t)m * 64 * 64, 64, 64, (bf16_t*)(p.WS() + W_WG) + (size_t)m * 128 * 64 + which * 64 * 64, 64, 0, lds, tid); continue; }
      x -= 64;
      if (x < 256) { const int m = x / 16; tp_mat(p.IN(3) + (size_t)m * 512 * 128, 512, 128, (bf16_t*)(p.WS() + W_CVAT) + (size_t)m * 128 * 512, 512, x % 16, lds, tid); continue; }
      x -= 256;
      { const int m = x / 16; tpw_mat(p.IN(5) + (size_t)m * 512 * 512, 512, 512, (bf16_t*)(p.WS() + W_CVBT) + (size_t)m * 512 * 512, 512, x % 16, lds, tid); }
    } else if (it < N_ADA + N_TP + N_CV) {
      int x = it - N_ADA - N_TP;
      const float* src; bf16_t* dst;
      if (x < 256) { src = p.IN(2); dst = (bf16_t*)(p.WS() + W_CKA); } else { x -= 256; src = p.IN(4); dst = (bf16_t*)(p.WS() + W_CKB); }
      const size_t e = (size_t)x * 4096 + tid * 8;
      const float4 a = *(const float4*)(src + e), b = *(const float4*)(src + e + 4);
      uint4 o; o.x = pk_bf16(a.x, a.y); o.y = pk_bf16(a.z, a.w); o.z = pk_bf16(b.x, b.y); o.w = pk_bf16(b.z, b.w);
      *(uint4*)(dst + e) = o;
    } else {
      float* rope = (float*)(p.WS() + W_ROPE);
      for (int e = tid; e < 1024; e += 512) {
        const int pos = e >> 4, i = e & 15;
        const float fr = ex2(-(float)i * (13.287712379549449f / 16.f));
        const float ang = (float)pos * fr;
        rope[e] = __cosf(ang); rope[1024 + e] = __sinf(ang);
      }
      int* ctr = (int*)(p.WS() + W_CTR);
      for (int e = tid; e < 2048; e += 512) ctr[e] = 0;
    }
  }
}

DEV void phase_modfin(const PV& p) {
  const float* mp = (const float*)(p.WS() + W_MODP);
  float* mo = (float*)(p.WS() + W_MOD);
  for (int e = blockIdx.x * 512 + ltid(); e < 2 * 9 * 3072; e += gridDim.x * 512) {
    const int l = e / (9 * 3072), rem = e % (9 * 3072), col = rem % 3072;
    float s = p.IN(11)[l * 3072 + col];
    for (int ks = 0; ks < KS_ADA; ++ks) s += mp[(size_t)ks * 2 * 9 * 3072 + (size_t)l * 9 * 3072 + rem];
    mo[e] = s;
  }
}

DEV void phase_norm(const PV& p, int stream, int l) {
  const int tix = ltid(); const int lane = tix & 63, wv = tix >> 6;
  const float* xin = (l == 0) ? p.IN(stream) : (p.OUT() + (size_t)stream * 8388608);
  const float* g = p.IN(9) + l * 1024;
  bf16_t* H = (bf16_t*)(p.WS() + W_H);
  const float* mod = (const float*)(p.WS() + W_MOD);
  for (int row = blockIdx.x * 8 + wv; row < NTOK; row += gridDim.x * 8) {
    const int j = stream ? 1 + (row >> 10) : 0;
    const float* mj = mod + (size_t)(l * 9 + j) * 3072;
    const float* xr = xin + (size_t)row * 1024;
    float4 xv[4]; float ss = 0.f;
#pragma unroll
    for (int q = 0; q < 4; ++q) { xv[q] = *(const float4*)(xr + q * 256 + lane * 4); ss += xv[q].x * xv[q].x + xv[q].y * xv[q].y + xv[q].z * xv[q].z + xv[q].w * xv[q].w; }
#pragma unroll
    for (int o = 32; o >= 1; o >>= 1) ss += __shfl_xor(ss, o);
    const float rstd = rsqrtf(ss * (1.f / 1024.f) + 1e-6f);
#pragma unroll
    for (int q = 0; q < 4; ++q) {
      const int col = q * 256 + lane * 4;
      const float4 gv = *(const float4*)(g + col), sh = *(const float4*)(mj + col), sc = *(const float4*)(mj + 1024 + col);
      store_bf16x4(H + ((size_t)((row >> 8) * 32 + (col >> 5)) * 256 + (row & 255)) * 32 + (col & 31),
                   xv[q].x * rstd * gv.x * (1.f + sc.x) + sh.x, xv[q].y * rstd * gv.y * (1.f + sc.y) + sh.y,
                   xv[q].z * rstd * gv.z * (1.f + sc.z) + sh.z, xv[q].w * rstd * gv.w * (1.f + sc.w) + sh.w);
    }
  }
}

DEV void gemm_stage(const bf16_t* A, int lda, const bf16_t* Bt, int ldb, int k0, unsigned char* st, int tid) {
#pragma unroll
  for (int i = 0; i < 4; ++i) {
    const int pp = i * 512 + tid, row = pp >> 3, ch = (pp & 7) ^ (row & 7);
    __builtin_amdgcn_global_load_lds((const void*)(A + (size_t)row * lda + k0 + ch * 8), (LAS void*)(st + pp * 16), 16, 0, 0);
  }
#pragma unroll
  for (int i = 0; i < 2; ++i) {
    const int pp = i * 512 + tid, row = pp >> 3, ch = (pp & 7) ^ (row & 7);
    __builtin_amdgcn_global_load_lds((const void*)(Bt + (size_t)row * ldb + k0 + ch * 8), (LAS void*)(st + GA_BYTES + pp * 16), 16, 0, 0);
  }
}

DEV void gemm_compute(const unsigned char* st, f32x4 (&acc)[4][4], int wr, int wc, int fr, int quad) {
#pragma unroll
  for (int ks = 0; ks < 2; ++ks) {
    bf16x8 af[4], bfr[4];
    const int ch = ((ks * 4 + quad) ^ (fr & 7)) * 16;
#pragma unroll
    for (int m = 0; m < 4; ++m) af[m] = *(const bf16x8*)(st + (wr * 64 + m * 16 + fr) * 128 + ch);
#pragma unroll
    for (int n = 0; n < 4; ++n) bfr[n] = *(const bf16x8*)(st + GA_BYTES + (wc * 64 + n * 16 + fr) * 128 + ch);
#pragma unroll
    for (int m = 0; m < 4; ++m)
#pragma unroll
      for (int n = 0; n < 4; ++n) acc[m][n] = mfma16(bfr[n], af[m], acc[m][n]);
  }
}

DEV void gemm_kloop(const bf16_t* A, int lda, const bf16_t* Bt, int ldb, int K, unsigned char* smem, f32x4 (&acc)[4][4], int wr, int wc, int fr, int quad, int tid) {
  const int nt = K >> 6;
  asm volatile("s_waitcnt vmcnt(0)" ::: "memory");
  __syncthreads();
  gemm_stage(A, lda, Bt, ldb, 0, smem, tid);
  gemm_stage(A, lda, Bt, ldb, 64, smem + GSTAGE, tid);
  int cur = 0;
  for (int t = 0; t < nt; ++t) {
    if (t + 1 < nt) asm volatile("s_waitcnt vmcnt(6)" ::: "memory"); else asm volatile("s_waitcnt vmcnt(0)" ::: "memory");
    __builtin_amdgcn_s_barrier();
    if (t + 2 < nt) { int nb = cur + 2; nb = (nb >= 3) ? nb - 3 : nb; gemm_stage(A, lda, Bt, ldb, (t + 2) * 64, smem + nb * GSTAGE, tid); }
    gemm_compute(smem + cur * GSTAGE, acc, wr, wc, fr, quad);
    cur = (cur == 2) ? 0 : cur + 1;
  }
  __syncthreads();
}

DEV void inproj_epilogue_rows(const PV& p, int stream, int l, int tok, int pn, int cl, int hf, const float* eprow, unsigned char* orow) {
  const int col = pn * 128 + cl;
  float v[32];
#pragma unroll
  for (int q = 0; q < 8; ++q) { const float4 t4 = *(const float4*)(eprow + q * 4); v[q * 4] = t4.x; v[q * 4 + 1] = t4.y; v[q * 4 + 2] = t4.z; v[q * 4 + 3] = t4.w; }
  bf16_t* P = (bf16_t*)(p.WS() + W_P);
  const int T = stream ? 1024 : 256;
  const int bb = stream ? (tok >> 10) : (tok >> 8), tt = stream ? (tok & 1023) : (tok & 255);
  const bool isQK = (pn <= 4) || (pn >= 10 && pn < 18);
  const bool isV = (pn == 5) || (pn >= 18 && pn < 22);
  if (isQK) {
    const float* nw = ((pn < 4) ? p.IN(13) : (pn == 4) ? p.IN(14) : (pn < 14) ? p.IN(16) : p.IN(17)) + l * 64 + hf * 32;
    float ss = 0.f;
#pragma unroll
    for (int i = 0; i < 32; ++i) ss += v[i] * v[i];
    ss += __shfl_xor(ss, 1);
    const float rstd = rsqrtf(ss * (1.f / 64.f) + 1e-6f);
#pragma unroll
    for (int i = 0; i < 32; ++i) v[i] = v[i] * rstd * nw[i];
    if (stream && pn <= 4) {
      const int pos = hf ? (tt & 63) : (tt >> 6);
      const float* rc = (const float*)(p.WS() + W_ROPE) + pos * 16;
#pragma unroll
      for (int i = 0; i < 16; ++i) {
        const float c = rc[i], s = rc[1024 + i], x1 = v[i], x2 = v[16 + i];
        v[i] = x1 * c - x2 * s; v[16 + i] = x2 * c + x1 * s;
      }
    }
  }
  if (!stream) {
    float* dst = nullptr;
    if (pn == 4) dst = p.OUT() + O_KA + ((size_t)(bb * 2 + l) * 256 + tt) * 128 + cl;
    else if (pn == 5) dst = p.OUT() + O_VA + ((size_t)(bb * 2 + l) * 256 + tt) * 128 + cl;
    else if (pn >= 14 && pn < 18) dst = p.OUT() + O_KB + ((size_t)(bb * 2 + l) * 256 + tt) * 512 + (pn - 14) * 128 + cl;
    else if (pn >= 18 && pn < 22) dst = p.OUT() + O_VB + ((size_t)(bb * 2 + l) * 256 + tt) * 512 + (pn - 18) * 128 + cl;
    if (dst) {
#pragma unroll
      for (int q = 0; q < 8; ++q) *(float4*)(dst + q * 4) = make_float4(v[q * 4], v[q * 4 + 1], v[q * 4 + 2], v[q * 4 + 3]);
    }
  }
  if (isV) return;
  if (!isQK) {
    const bool silu = (pn >= 6 && pn < 10) || (pn >= 22 && pn < 26) || (pn >= 30 && pn < 34);
    const bool sg = (pn >= 34);
    if (silu) {
#pragma unroll
      for (int i = 0; i < 32; ++i) v[i] = v[i] * sigm(v[i]);
    } else if (sg) {
#pragma unroll
      for (int i = 0; i < 32; ++i) v[i] = sigm(v[i]);
    }
  }
#pragma unroll
  for (int q = 0; q < 4; ++q) {
    uint4 o; o.x = pk_bf16(v[q * 8], v[q * 8 + 1]); o.y = pk_bf16(v[q * 8 + 2], v[q * 8 + 3]); o.z = pk_bf16(v[q * 8 + 4], v[q * 8 + 5]); o.w = pk_bf16(v[q * 8 + 6], v[q * 8 + 7]);
    *(uint4*)(orow + q * 16) = o;
  }
}

constexpr int G2_STAGE = 32768;
DEV void g2_stage(const bf16_t* A, int lda, const bf16_t* Bt, int ldb, int k0, unsigned char* st, int tid) {
  const int ko = k0 * 256;
#pragma unroll
  for (int i = 0; i < 2; ++i) {
    const int pp = i * 512 + tid, row = pp >> 2, ch = (pp & 3) ^ ((row >> 2) & 3);
    __builtin_amdgcn_global_load_lds((const void*)(A + (size_t)row * 32 + ko + ch * 8), (LAS void*)(st + pp * 16), 16, 0, 0);
  }
#pragma unroll
  for (int i = 0; i < 2; ++i) {
    const int pp = i * 512 + tid, row = pp >> 2, ch = (pp & 3) ^ ((row >> 2) & 3);
    __builtin_amdgcn_global_load_lds((const void*)(Bt + (size_t)row * 32 + ko + ch * 8), (LAS void*)(st + 16384 + pp * 16), 16, 0, 0);
  }
}
struct G2B { bf16x8 v[4]; };
struct G2A { bf16x8 v[4]; };
DEV void g2_read_b(G2B& f, const unsigned char* st, int wc, int fr, int quad) {
  const int ch = (quad ^ ((fr >> 2) & 3)) * 16;
#pragma unroll
  for (int n = 0; n < 4; ++n) f.v[n] = *(const bf16x8*)(st + 16384 + (wc * 64 + n * 16 + fr) * 64 + ch);
}
DEV void g2_read_a(G2A& f, const unsigned char* st, int half, int wr, int fr, int quad) {
  const int ch = (quad ^ ((fr >> 2) & 3)) * 16;
#pragma unroll
  for (int m = 0; m < 4; ++m) f.v[m] = *(const bf16x8*)(st + (wr * 128 + (half * 4 + m) * 16 + fr) * 64 + ch);
}
template <int HALF>
DEV void g2_mma(const G2B& b, const G2A& a, f32x4 (&acc)[8][4]) {
#pragma unroll
  for (int m = 0; m < 4; ++m)
#pragma unroll
    for (int n = 0; n < 4; ++n) acc[HALF * 4 + m][n] = mfma16(b.v[n], a.v[m], acc[HALF * 4 + m][n]);
}
DEV void g2_kloop(const bf16_t* A, int lda, const bf16_t* Bt, int ldb, int K, unsigned char* smem, f32x4 (&acc)[8][4], int wr, int wc, int fr, int quad, int tid) {
  const int nt = K >> 5;
  asm volatile("s_waitcnt vmcnt(0)" ::: "memory");
  __syncthreads();
  g2_stage(A, lda, Bt, ldb, 0, smem, tid);
  g2_stage(A, lda, Bt, ldb, 32, smem + G2_STAGE, tid);
  g2_stage(A, lda, Bt, ldb, 64, smem + 2 * G2_STAGE, tid);
  asm volatile("s_waitcnt vmcnt(8)" ::: "memory");
  __builtin_amdgcn_s_barrier();
  G2B bb; G2A a0, a1;
  g2_read_b(bb, smem, wc, fr, quad);
  g2_read_a(a0, smem, 0, wr, fr, quad);
  for (int t = 0; t < nt; ++t) {
    const bool more = (t + 1 < nt);
    if (more) {
      if (t + 2 < nt) asm volatile("s_waitcnt vmcnt(4)" ::: "memory"); else asm volatile("s_waitcnt vmcnt(0)" ::: "memory");
      asm volatile("s_waitcnt lgkmcnt(0)" ::: "memory");
      __builtin_amdgcn_s_barrier();
      if (t + 3 < nt) g2_stage(A, lda, Bt, ldb, (t + 3) * 32, smem + ((t + 3) & 3) * G2_STAGE, tid);
    }
    g2_read_a(a1, smem + (t & 3) * G2_STAGE, 1, wr, fr, quad);
    g2_mma<0>(bb, a0, acc);
    if (more) g2_read_a(a0, smem + ((t + 1) & 3) * G2_STAGE, 0, wr, fr, quad);
    g2_mma<1>(bb, a1, acc);
    if (more) g2_read_b(bb, smem + ((t + 1) & 3) * G2_STAGE, wc, fr, quad);
  }
  __syncthreads();
}

constexpr int EP2_LD = 260;
DEV void phase_inproj(const PV& p, int stream, int l, unsigned char* smem) {
  const int tix = ltid(); const int lane = tix & 63, wv = tix >> 6, wr = wv >> 2, wc = wv & 3, fr = lane & 15, quad = lane >> 4;
  const bf16_t* H = (const bf16_t*)(p.WS() + W_H);
  const bf16_t* Wt = (const bf16_t*)(p.WS() + W_WT_IN) + (size_t)l * NCOL * 1024;
  float* ep = (float*)smem;
  unsigned char* ost = smem + 64 * EP2_LD * 4;
  constexpr int OST_LD = 528;
  for (int t = blockIdx.x; t < 4 * 256; t += gridDim.x) {
    const int rr = t >> 8, xcd = t & 7, j = (t & 255) >> 3, jj = j >> 2;
    const int pm = xcd * 4 + (j & 3);
    int pn;
    if (jj >= 5) { if (rr >= 3) continue; const int h = rr * 3 + (jj - 5); pn = (h < 3) ? h : h + 2; }
    else { const int q = rr * 5 + jj; pn = (q < 2) ? q + 3 : q + 9; }
    f32x4 acc[8][4];
#pragma unroll
    for (int m = 0; m < 8; ++m)
#pragma unroll
      for (int n = 0; n < 4; ++n) acc[m][n] = (f32x4){0.f, 0.f, 0.f, 0.f};
    g2_kloop(H + (size_t)pm * 256 * 1024, 1024, Wt + (size_t)pn * 256 * 1024, 1024, 1024, smem, acc, wr, wc, fr, quad, tix);
    if (pn == 3 || pn == 4 || pn >= 11) {
      const int act = (pn == 13 || pn == 14) ? 0 : ((pn >= 17) ? 2 : 1);
#pragma unroll
      for (int m = 0; m < 8; ++m)
#pragma unroll
        for (int n = 0; n < 4; ++n) {
          float v0 = acc[m][n][0], v1 = acc[m][n][1], v2 = acc[m][n][2], v3 = acc[m][n][3];
          if (act) {
            const float s0 = sigm(v0), s1 = sigm(v1), s2 = sigm(v2), s3 = sigm(v3);
            if (act == 1) { v0 *= s0; v1 *= s1; v2 *= s2; v3 *= s3; } else { v0 = s0; v1 = s1; v2 = s2; v3 = s3; }
          }
          uint2 o; o.x = pk_bf16(v0, v1); o.y = pk_bf16(v2, v3);
          *(uint2*)(smem + (wr * 128 + m * 16 + fr) * 528 + (wc * 64 + n * 16 + 4 * quad) * 2) = o;
        }
      __syncthreads();
      bf16_t* Pw = (bf16_t*)(p.WS() + W_P) + (size_t)(pm * 256) * NCOL + pn * 256;
#pragma unroll 4
      for (int k = 0; k < 16; ++k) {
        const int idx = k * 512 + tix, row = idx >> 5, ch = idx & 31;
        *(uint4*)(Pw + (size_t)row * NCOL + ch * 8) = *(const uint4*)(smem + row * 528 + ch * 16);
      }
      continue;
    }
#pragma unroll
    for (int pass = 0; pass < 4; ++pass) {
      if (wr == (pass >> 1)) {
#pragma unroll
        for (int mm = 0; mm < 4; ++mm)
#pragma unroll
          for (int n = 0; n < 4; ++n) *(f32x4*)(ep + (mm * 16 + fr) * EP2_LD + wc * 64 + n * 16 + 4 * quad) = acc[(pass & 1) * 4 + mm][n];
      }
      __syncthreads();
      {
        const int r = tix >> 3, cg4 = (tix >> 1) & 3, hf = tix & 1;
        inproj_epilogue_rows(p, stream, l, pm * 256 + pass * 64 + r, pn * 2 + (cg4 >> 1), (cg4 & 1) * 64 + hf * 32, hf, ep + r * EP2_LD + cg4 * 64 + hf * 32,
                             ost + r * OST_LD + cg4 * 128 + hf * 64);
      }
      if (pn == 2 || pn == 9 || pn == 10) {
        const int c = tix >> 1, hfr = tix & 1, pn128 = pn * 2 + (c >> 7), cl = c & 127;
        if (pn128 == 5 || pn128 >= 18) {
          const int T = stream ? 1024 : 256;
          const int tok0 = pm * 256 + pass * 64 + hfr * 32;
          const int bb = stream ? (tok0 >> 10) : (tok0 >> 8), tt0 = stream ? (tok0 & 1023) : (tok0 & 255);
          bf16_t* vt = (pn128 == 5) ? (bf16_t*)(p.WS() + W_VAT) + ((size_t)bb * 128 + cl) * T + tt0
                                    : (bf16_t*)(p.WS() + W_VBT) + ((size_t)bb * 512 + (pn128 - 18) * 128 + cl) * T + tt0;
          const float* ec = ep + (hfr * 32) * EP2_LD + c;
#pragma unroll
          for (int q = 0; q < 4; ++q) {
            uint4 o;
            o.x = pk_bf16(ec[(q * 8 + 0) * EP2_LD], ec[(q * 8 + 1) * EP2_LD]); o.y = pk_bf16(ec[(q * 8 + 2) * EP2_LD], ec[(q * 8 + 3) * EP2_LD]);
            o.z = pk_bf16(ec[(q * 8 + 4) * EP2_LD], ec[(q * 8 + 5) * EP2_LD]); o.w = pk_bf16(ec[(q * 8 + 6) * EP2_LD], ec[(q * 8 + 7) * EP2_LD]);
            *(uint4*)(vt + q * 8) = o;
          }
        }
      }
      __syncthreads();
      {
        bf16_t* Pw = (bf16_t*)(p.WS() + W_P) + (size_t)(pm * 256 + pass * 64) * NCOL + pn * 256;
#pragma unroll 1
        for (int k = 0; k < 4; ++k) {
          const int idx = k * 512 + tix, row = idx >> 5, ch = idx & 31;
          const int pn128 = pn * 2 + (ch >> 4);
          if (!(pn128 == 5 || (pn128 >= 18 && pn128 < 22))) *(uint4*)(Pw + (size_t)row * NCOL + ch * 8) = *(const uint4*)(ost + row * OST_LD + ch * 16);
        }
      }
      __syncthreads();
    }
  }
}

constexpr int AT_BUF = 16384;
constexpr int AT_RPB = 32768;
constexpr int AT_LRU = 36864;
constexpr int AT_MISC = 53248;

template <int NQ> struct AttnState { bf16x8 qf[NQ][2]; f32x4 o[NQ][4]; float m[NQ], l[NQ]; };
struct ChunkSrc { const bf16_t* K; int ldk; const bf16_t* VT; int ldvt; };

template <int NQ>
DEV void attn_init(AttnState<NQ>& st, const bf16_t* Q, int fr, int quad, float m0, float l0) {
#pragma unroll
  for (int nq = 0; nq < NQ; ++nq) {
#pragma unroll
    for (int ks = 0; ks < 2; ++ks) {
      const uint4 raw = *(const uint4*)(Q + (size_t)(nq * 16 + fr) * NCOL + ks * 32 + quad * 8);
      const unsigned w[4] = {raw.x, raw.y, raw.z, raw.w};
      union { bf16x8 v; unsigned u[4]; } qq;
#pragma unroll
      for (int e = 0; e < 4; ++e) qq.u[e] = pk_bf16(__uint_as_float(w[e] << 16) * (0.125f * LOG2E), __uint_as_float(w[e] & 0xffff0000u) * (0.125f * LOG2E));
      st.qf[nq][ks] = qq.v;
    }
#pragma unroll
    for (int mb = 0; mb < 4; ++mb) st.o[nq][mb] = (f32x4){0.f, 0.f, 0.f, 0.f};
    st.m[nq] = m0; st.l[nq] = (quad == 0) ? l0 : 0.f;
  }
}

DEV void attn_stage(const ChunkSrc& c, unsigned char* buf, int tid) {
  const int row = tid >> 3, ch = (tid & 7) ^ (row & 7);
  __builtin_amdgcn_global_load_lds((const void*)(c.K + (size_t)row * c.ldk + ch * 8), (LAS void*)(buf + tid * 16), 16, 0, 0);
  __builtin_amdgcn_global_load_lds((const void*)(c.VT + (size_t)row * c.ldvt + ch * 8), (LAS void*)(buf + 8192 + tid * 16), 16, 0, 0);
}

template <int NQ, class F>
DEV void attn_chunk(AttnState<NQ>& st, const unsigned char* buf, int fr, int quad, int gmask, F&& bias) {
  const int sw = fr & 7;
  float sv[NQ][2][8];
#pragma unroll
  for (int g = 0; g < 2; ++g) {
    if (!((gmask >> g) & 1)) continue;
    bf16x8 kf[2][2];
#pragma unroll
    for (int bl = 0; bl < 2; ++bl)
#pragma unroll
      for (int ks = 0; ks < 2; ++ks) kf[bl][ks] = *(const bf16x8*)(buf + ((g * 2 + bl) * 16 + fr) * 128 + (((ks * 4 + quad) ^ sw) * 16));
#pragma unroll
    for (int nq = 0; nq < NQ; ++nq)
#pragma unroll
      for (int bl = 0; bl < 2; ++bl) {
        f32x4 s = mfma16(kf[bl][0], st.qf[nq][0], (f32x4){0.f, 0.f, 0.f, 0.f});
        s = mfma16(kf[bl][1], st.qf[nq][1], s);
#pragma unroll
        for (int i = 0; i < 4; ++i) sv[nq][g][bl * 4 + i] = bias(nq, g * 32 + bl * 16 + 4 * quad + i, s[i]);
      }
  }
  float alpha[NQ];
#pragma unroll
  for (int nq = 0; nq < NQ; ++nq) {
    float mx = -3.0e38f;
#pragma unroll
    for (int g = 0; g < 2; ++g) {
      if (!((gmask >> g) & 1)) continue;
#pragma unroll
      for (int i = 0; i < 8; ++i) mx = fmaxf(mx, sv[nq][g][i]);
    }
    mx = quad_max(mx);
    const float mn = fmaxf(st.m[nq], mx);
    alpha[nq] = ex2(st.m[nq] - mn);
    st.m[nq] = mn;
    float ps = 0.f;
#pragma unroll
    for (int g = 0; g < 2; ++g) {
      if (!((gmask >> g) & 1)) continue;
#pragma unroll
      for (int i = 0; i < 8; ++i) { sv[nq][g][i] = ex2(sv[nq][g][i] - mn); ps += sv[nq][g][i]; }
    }
    st.l[nq] = st.l[nq] * alpha[nq] + ps;
#pragma unroll
    for (int mb = 0; mb < 4; ++mb) { st.o[nq][mb][0] *= alpha[nq]; st.o[nq][mb][1] *= alpha[nq]; st.o[nq][mb][2] *= alpha[nq]; st.o[nq][mb][3] *= alpha[nq]; }
  }
#pragma unroll
  for (int g = 0; g < 2; ++g) {
    if (!((gmask >> g) & 1)) continue;
    bf16x8 vf[4];
#pragma unroll
    for (int mb = 0; mb < 4; ++mb) {
      const unsigned char* vr = buf + 8192 + (mb * 16 + fr) * 128 + (quad & 1) * 8;
      const bf16x4 lo = *(const bf16x4*)(vr + (((g * 4 + (quad >> 1)) ^ sw) * 16));
      const bf16x4 hi = *(const bf16x4*)(vr + (((g * 4 + 2 + (quad >> 1)) ^ sw) * 16));
      vf[mb] = (bf16x8){lo[0], lo[1], lo[2], lo[3], hi[0], hi[1], hi[2], hi[3]};
    }
#pragma unroll
    for (int nq = 0; nq < NQ; ++nq) {
      union { bf16x8 v; unsigned u[4]; } pb;
      pb.u[0] = pk_bf16(sv[nq][g][0], sv[nq][g][1]); pb.u[1] = pk_bf16(sv[nq][g][2], sv[nq][g][3]);
      pb.u[2] = pk_bf16(sv[nq][g][4], sv[nq][g][5]); pb.u[3] = pk_bf16(sv[nq][g][6], sv[nq][g][7]);
#pragma unroll
      for (int mb = 0; mb < 4; ++mb) st.o[nq][mb] = mfma16(vf[mb], pb.v, st.o[nq][mb]);
    }
  }
}

constexpr int AT_GATE = 65536, AT_OUT = 98304;
template <int NQ>
DEV void attn_gate_prefetch(const bf16_t* row0, int gcol, unsigned char* wg, int lane) {
#pragma unroll
  for (int k = 0; k < NQ * 2; ++k) {
    const int idx = k * 64 + lane, row = idx >> 3, ch = (idx & 7) ^ (row & 7);
    __builtin_amdgcn_global_load_lds((const void*)(row0 + (size_t)row * NCOL + gcol + ch * 8), (LAS void*)(wg + idx * 16), 16, 0, 0);
  }
}
template <int NQ>
DEV void attn_finish(AttnState<NQ>& st, const unsigned char* wg, unsigned char* wo, bf16_t* yrow0, int ycol, int lane, int fr, int quad) {
#pragma unroll
  for (int nq = 0; nq < NQ; ++nq) {
    float l = st.l[nq];
    l += __shfl_xor(l, 16); l += __shfl_xor(l, 32);
    const float inv = 1.f / l;
    const int row = nq * 16 + fr;
#pragma unroll
    for (int mb = 0; mb < 4; ++mb) {
      const int d0 = mb * 16 + 4 * quad;
      const int off = row * 128 + ((((d0 >> 3) ^ (row & 7))) << 4) + ((d0 & 7) << 1);
      const bf16x4 g = *(const bf16x4*)(wg + off);
      const f32x4 o = st.o[nq][mb];
      uint2 v; v.x = pk_bf16(o[0] * inv * bf2f((unsigned short)g[0]), o[1] * inv * bf2f((unsigned short)g[1]));
      v.y = pk_bf16(o[2] * inv * bf2f((unsigned short)g[2]), o[3] * inv * bf2f((unsigned short)g[3]));
      *(uint2*)(wo + off) = v;
    }
  }
  __builtin_amdgcn_fence(__ATOMIC_RELEASE, "wavefront");
  __builtin_amdgcn_wave_barrier();
  __builtin_amdgcn_fence(__ATOMIC_ACQUIRE, "wavefront");
#pragma unroll
  for (int k = 0; k < NQ * 2; ++k) {
    const int idx = k * 64 + lane, row = idx >> 3, ch = idx & 7;
    *(uint4*)(yrow0 + (size_t)row * 1024 + ycol + ch * 8) = *(const uint4*)(wo + row * 128 + ((ch ^ (row & 7)) << 4));
  }
  __builtin_amdgcn_wave_barrier();
}

template <class S, class B>
DEV void attn_pipeline(int nch, unsigned char* smem, int tid, S&& src, B&& body) {
  attn_stage(src(0), smem, tid);
  for (int c = 0; c < nch; ++c) {
    asm volatile("s_waitcnt vmcnt(0)" ::: "memory");
    __syncthreads();
    if (c + 1 < nch) attn_stage(src(c + 1), smem + ((c + 1) & 1) * AT_BUF, tid);
    body(c, smem + (c & 1) * AT_BUF);
  }
  asm volatile("s_waitcnt vmcnt(0)" ::: "memory");
  __syncthreads();
}

DEV void attn_ctx_item(const PV& p, int l, int item, unsigned char* smem, int tid, int wv, int fr, int quad) {
  bf16_t* P = (bf16_t*)(p.WS() + W_P);
  const int isB = item >> 8, x = item & 255, b = x >> 3, sub = x & 7;
  int hq, tok0, qcol, gcol; const bf16_t *K, *VT; float m0, l0;
  if (!isB) {
    const int kvh = sub >> 2, qb = sub & 3;
    hq = kvh * 4 + (wv >> 1); tok0 = b * 256 + qb * 64 + (wv & 1) * 32;
    qcol = C_AQ + hq * 64; gcol = C_AG + hq * 64;
    K = P + (size_t)b * 256 * NCOL + C_AK + kvh * 64;
    VT = (const bf16_t*)(p.WS() + W_VAT) + ((size_t)b * 128 + kvh * 64) * 256;
    m0 = p.IN(15)[l * 8 + hq] * LOG2E; l0 = 1.f;
  } else {
    hq = sub; tok0 = b * 256 + wv * 32;
    qcol = C_BQ + hq * 64; gcol = C_BG + hq * 64;
    K = P + (size_t)b * 256 * NCOL + C_BK + hq * 64;
    VT = (const bf16_t*)(p.WS() + W_VBT) + ((size_t)b * 512 + hq * 64) * 256;
    m0 = -1e30f; l0 = 0.f;
  }
  bf16_t* row0 = P + (size_t)tok0 * NCOL;
  AttnState<2> st;
  attn_init<2>(st, row0 + qcol, fr, quad, m0, l0);
  attn_gate_prefetch<2>(row0, gcol, smem + AT_GATE + wv * 4096, tid & 63);
  attn_pipeline(4, smem, tid,
                [&](int c) { return ChunkSrc{K + (size_t)c * 64 * NCOL, NCOL, VT + c * 64, 256}; },
                [&](int, const unsigned char* buf) { attn_chunk<2>(st, buf, fr, quad, 3, [](int, int, float v) { return v; }); });
  attn_finish<2>(st, smem + AT_GATE + wv * 4096, smem + AT_OUT + wv * 4096, (bf16_t*)(p.WS() + W_Y) + (size_t)tok0 * 1024, isB * 512 + hq * 64, tid & 63, fr, quad);
}

DEV void attn_latA_item(const PV& p, int l, int item, unsigned char* smem, int tid, int wv, int fr, int quad) {
  bf16_t* P = (bf16_t*)(p.WS() + W_P);
  const int b = item >> 5, kvh = (item >> 4) & 1, qb = item & 15;
  const int hq = kvh * 4 + (wv >> 1), q0w = qb * 64 + (wv & 1) * 32;
  bf16_t* row0 = P + (size_t)(b * 1024 + q0w) * NCOL;
  const int qcol = C_AQ + hq * 64, gcol = C_AG + hq * 64;
  AttnState<2> st;
  attn_init<2>(st, row0 + qcol, fr, quad, p.IN(15)[l * 8 + hq] * LOG2E, 1.f);
  attn_gate_prefetch<2>(row0, gcol, smem + AT_GATE + wv * 4096, tid & 63);
  const bf16_t* Kc = (const bf16_t*)(p.WS() + W_CKA) + (size_t)(b * 2 + l) * 512 * 128 + kvh * 64;
  const bf16_t* VTc = (const bf16_t*)(p.WS() + W_CVAT) + ((size_t)(b * 2 + l) * 128 + kvh * 64) * 512;
  const bf16_t* Kl = P + (size_t)b * 1024 * NCOL + C_AK + kvh * 64;
  const bf16_t* VTl = (const bf16_t*)(p.WS() + W_VAT) + ((size_t)b * 128 + kvh * 64) * 1024;
  const int k_lo = (qb * 64 - 128 < 0) ? 0 : qb * 64 - 128, k_hi = (qb * 64 + 192 > 1024) ? 1024 : qb * 64 + 192;
  const int nch = 8 + ((k_hi - k_lo) >> 6);
  attn_pipeline(nch, smem, tid,
                [&](int c) { if (c < 8) return ChunkSrc{Kc + (size_t)c * 64 * 128, 128, VTc + c * 64, 512};
                             const int k0 = k_lo + (c - 8) * 64; return ChunkSrc{Kl + (size_t)k0 * NCOL, NCOL, VTl + k0, 1024}; },
                [&](int c, const unsigned char* buf) {
                  if (c < 8) { attn_chunk<2>(st, buf, fr, quad, 3, [](int, int, float v) { return v; }); return; }
                  const int k0 = k_lo + (c - 8) * 64;
                  int gm = 0;
                  if (k0 + 31 >= q0w - 128 && k0 <= q0w + 31 + 128) gm |= 1;
                  if (k0 + 63 >= q0w - 128 && k0 + 32 <= q0w + 31 + 128) gm |= 2;
                  attn_chunk<2>(st, buf, fr, quad, gm, [&](int nq, int kk, float v) { const int dd = (q0w + nq * 16 + fr) - (k0 + kk); return (dd <= 128 && dd >= -128) ? v : -1e30f; });
                });
  attn_finish<2>(st, smem + AT_GATE + wv * 4096, smem + AT_OUT + wv * 4096, (bf16_t*)(p.WS() + W_Y) + (size_t)(b * 1024 + q0w) * 1024, hq * 64, tid & 63, fr, quad);
}

DEV void attn_latB_item(const PV& p, int l, int item, unsigned char* smem, int tid, int wv, int fr, int quad) {
  bf16_t* P = (bf16_t*)(p.WS() + W_P);
  const int b = item >> 6, h = (item >> 3) & 7, rp = item & 7;
  const int r = 2 * rp + (wv >> 2), jb = wv & 3;
  bf16_t* row0 = P + (size_t)(b * 1024 + r * 64 + jb * 16) * NCOL;
  const int qcol = C_BQ + h * 64, gcol = C_BG + h * 64;
  float* rpl = (float*)(smem + AT_RPB);
  { const float* rpb = p.IN(18) + (size_t)(l * 8 + h) * 15 * 31; if (tid < 465) rpl[tid] = rpb[tid]; }
  AttnState<1> st;
  attn_init<1>(st, row0 + qcol, fr, quad, -1e30f, 0.f);
  attn_gate_prefetch<1>(row0, gcol, smem + AT_GATE + wv * 4096, tid & 63);
  const bf16_t* Kc = (const bf16_t*)(p.WS() + W_CKB) + (size_t)(b * 2 + l) * 512 * 512 + h * 64;
  const bf16_t* VTc = (const bf16_t*)(p.WS() + W_CVBT) + ((size_t)(b * 2 + l) * 512 + h * 64) * 512;
  const bf16_t* Kl = P + (size_t)b * 1024 * NCOL + C_BK + h * 64;
  const bf16_t* VTl = (const bf16_t*)(p.WS() + W_VBT) + ((size_t)b * 512 + h * 64) * 1024;
  const int r0 = 2 * rp;
  const int rs0 = (r0 - 4 < 0) ? 0 : ((r0 - 4 > 8) ? 8 : r0 - 4);
  const int rs1 = (r0 - 3 < 0) ? 0 : ((r0 - 3 > 8) ? 8 : r0 - 3);
  const int rs = (wv >> 2) ? rs1 : rs0;
  const int nch = 8 + (rs1 + 8 - rs0);
  const int qc = jb * 16 + fr;
  const int cs = (qc - 8 < 0) ? 0 : ((qc - 8 > 48) ? 48 : qc - 8);
  const int gmw = (jb == 0) ? 1 : ((jb == 3) ? 2 : 3);
  attn_pipeline(nch, smem, tid,
                [&](int c) { if (c < 8) return ChunkSrc{Kc + (size_t)c * 64 * 512, 512, VTc + c * 64, 512};
                             const int key0 = (rs0 + c - 8) * 64; return ChunkSrc{Kl + (size_t)key0 * NCOL, NCOL, VTl + key0, 1024}; },
                [&](int c, const unsigned char* buf) {
                  if (c < 8) { attn_chunk<1>(st, buf, fr, quad, 3, [](int, int, float v) { return v; }); return; }
                  const int krow = rs0 + c - 8;
                  if (krow < rs || krow >= rs + 8) return;
                  const float* rp_ = rpl + (krow - r + 7) * 31;
                  attn_chunk<1>(st, buf, fr, quad, gmw, [&](int, int kc, float v) {
                    int dc = kc - qc + 15; dc = dc < 0 ? 0 : (dc > 30 ? 30 : dc);
                    const float bv = rp_[dc];
                    return (kc >= cs && kc < cs + 16) ? v + bv * LOG2E : -1e30f; });
                });
  attn_finish<1>(st, smem + AT_GATE + wv * 4096, smem + AT_OUT + wv * 4096, (bf16_t*)(p.WS() + W_Y) + (size_t)(b * 1024 + r * 64 + jb * 16) * 1024, 512 + h * 64, tid & 63, fr, quad);
}

DEV void lru_load(const bf16_t* P, size_t tokbase, int T, int t0, int quad, int ch0, uint2 (&cx)[7]) {
#pragma unroll
  for (int rr = 0; rr < 7; ++rr) {
    const int t = t0 + 4 * quad - 2 + rr;
    cx[rr] = make_uint2(0u, 0u);
    if (t >= 0 && t < T) cx[rr] = *(const uint2*)(P + (tokbase + t) * NCOL + C_CX + ch0);
  }
}

DEV void lru_item(const PV& p, int stream, int l, int item, unsigned char* wl, int lane, int fr, int quad) {
  const int dir = item & 1, n = (item >> 1) & 7, gc = item >> 4;
  const int T = stream ? 1024 : 256;
  const int seq = stream ? (gc >> 4) : (gc >> 2), cidx = stream ? (gc & 15) : (gc & 3);
  const bf16_t* P = (const bf16_t*)(p.WS() + W_P);
  const size_t tokbase = (size_t)seq * T;
  const int ch0 = n * 64 + 4 * fr;
  const bf16_t* wg = (const bf16_t*)(p.WS() + W_WG) + (size_t)((l * 2 + dir) * 8 + n) * 128 * 64;
  bf16x8 wfa[4][2], wfx[4][2];
#pragma unroll
  for (int nb = 0; nb < 4; ++nb)
#pragma unroll
    for (int ks = 0; ks < 2; ++ks) {
      wfa[nb][ks] = *(const bf16x8*)(wg + (4 * fr + nb) * 64 + ks * 32 + quad * 8);
      wfx[nb][ks] = *(const bf16x8*)(wg + (64 + 4 * fr + nb) * 64 + ks * 32 + quad * 8);
    }
  float cb[4], ba[4], bx[4], sp2[4], H[4], AP[4];
  const float* cwp = p.IN(19) + (size_t)l * 4 * 512 + ch0;
  {
    const float4 c4 = *(const float4*)(p.IN(20) + l * 512 + ch0); cb[0] = c4.x; cb[1] = c4.y; cb[2] = c4.z; cb[3] = c4.w;
    const float4 a4 = *(const float4*)(p.IN(22) + (l * 2 + dir) * 512 + ch0); ba[0] = a4.x; ba[1] = a4.y; ba[2] = a4.z; ba[3] = a4.w;
    const float4 x4 = *(const float4*)(p.IN(24) + (l * 2 + dir) * 512 + ch0); bx[0] = x4.x; bx[1] = x4.y; bx[2] = x4.z; bx[3] = x4.w;
    const float4 l4 = *(const float4*)(p.IN(25) + (l * 2 + dir) * 512 + ch0);
    const float lm[4] = {l4.x, l4.y, l4.z, l4.w};
#pragma unroll
    for (int nb = 0; nb < 4; ++nb) { sp2[nb] = 8.f * LOG2E * logf(1.f + expf(-lm[nb])); H[nb] = 0.f; AP[nb] = 1.f; }
  }
  bf16_t* LOC = (bf16_t*)(p.WS() + W_HF) + (size_t)dir * NTOK * 512;
  bf16_t* APR = (bf16_t*)(p.WS() + W_H) + (size_t)dir * NTOK * 512;
  const int tc0 = cidx * 64;
  uint2 cxn[7];
  lru_load(P, tokbase, T, tc0 + (dir ? 3 : 0) * 16, quad, ch0, cxn);
  for (int step = 0; step < 4; ++step) {
    const int t0 = tc0 + (dir ? (3 - step) : step) * 16;
    uint2 cxr[7];
#pragma unroll
    for (int rr = 0; rr < 7; ++rr) cxr[rr] = cxn[rr];
    if (step + 1 < 4) lru_load(P, tokbase, T, tc0 + (dir ? (2 - step) : step + 1) * 16, quad, ch0, cxn);
    float cw[4][4];
#pragma unroll
    for (int j = 0; j < 4; ++j) { const float4 t4 = *(const float4*)(cwp + j * 512); cw[j][0] = t4.x; cw[j][1] = t4.y; cw[j][2] = t4.z; cw[j][3] = t4.w; }
    float xc[4][4];
#pragma unroll
    for (int i = 0; i < 4; ++i)
#pragma unroll
      for (int nb = 0; nb < 4; ++nb) {
        float s = cb[nb];
#pragma unroll
        for (int j = 0; j < 4; ++j) {
          const unsigned w = (nb < 2) ? cxr[i + j].x : cxr[i + j].y;
          const float cv = (nb & 1) ? __uint_as_float(w & 0xffff0000u) : __uint_as_float(w << 16);
          s += cv * cw[j][nb];
        }
        xc[i][nb] = s;
      }
    __builtin_amdgcn_wave_barrier();
#pragma unroll
    for (int i = 0; i < 4; ++i) { uint2 v; v.x = pk_bf16(xc[i][0], xc[i][1]); v.y = pk_bf16(xc[i][2], xc[i][3]); *(uint2*)(wl + (4 * quad + i) * 128 + fr * 8) = v; }
    __builtin_amdgcn_fence(__ATOMIC_RELEASE, "wavefront");
    __builtin_amdgcn_wave_barrier();
    __builtin_amdgcn_fence(__ATOMIC_ACQUIRE, "wavefront");
    bf16x8 af[2];
#pragma unroll
    for (int ks = 0; ks < 2; ++ks) af[ks] = *(const bf16x8*)(wl + fr * 128 + ks * 64 + quad * 16);
    __builtin_amdgcn_wave_barrier();
    float hv[4][4], av[4][4];
#pragma unroll
    for (int nb = 0; nb < 4; ++nb) {
      f32x4 ga = mfma16(af[0], wfa[nb][0], (f32x4){0.f, 0.f, 0.f, 0.f}); ga = mfma16(af[1], wfa[nb][1], ga);
      f32x4 gx = mfma16(af[0], wfx[nb][0], (f32x4){0.f, 0.f, 0.f, 0.f}); gx = mfma16(af[1], wfx[nb][1], gx);
      float a[4], u[4];
#pragma unroll
      for (int i = 0; i < 4; ++i) {
        const float r = sigm(ga[i] + ba[nb]), ig = sigm(gx[i] + bx[nb]);
        a[i] = ex2(-sp2[nb] * r);
        u[i] = sqrtf(fmaxf(0.f, 1.f - a[i] * a[i])) * ig * xc[i][nb];
      }
      float Ls[4], Pas[4], L = 0.f, Pa = 1.f;
#pragma unroll
      for (int ii = 0; ii < 4; ++ii) { const int i = dir ? 3 - ii : ii; L = a[i] * L + u[i]; Pa *= a[i]; Ls[i] = L; Pas[i] = Pa; }
      float c = H[nb], ap = AP[nb], cq = 0.f, aq = 1.f;
      float paq[4], luq[4];
      quad_gather(Pa, paq); quad_gather(L, luq);
#pragma unroll
      for (int qq = 0; qq < 4; ++qq) {
        const int q = dir ? 3 - qq : qq;
        const float pa_q = paq[q], lu_q = luq[q];
        if (q == quad) { cq = c; aq = ap; }
        c = pa_q * c + lu_q; ap *= pa_q;
      }
      H[nb] = c; AP[nb] = ap;
#pragma unroll
      for (int i = 0; i < 4; ++i) { hv[i][nb] = Ls[i] + Pas[i] * cq; av[i][nb] = Pas[i] * aq; }
    }
#pragma unroll
    for (int i = 0; i < 4; ++i) {
      const size_t e = (tokbase + t0 + 4 * quad + i) * 512 + ch0;
      store_bf16x4(LOC + e, hv[i][0], hv[i][1], hv[i][2], hv[i][3]);
      store_bf16x4(APR + e, av[i][0], av[i][1], av[i][2], av[i][3]);
    }
  }
  if (quad == 0) {
    float* sm = (float*)(p.WS() + W_MODP) + ((size_t)(gc * 8 + n) * 2 + dir) * 128 + 4 * fr;
    *(float4*)sm = make_float4(AP[0], AP[1], AP[2], AP[3]);
    *(float4*)(sm + 64) = make_float4(H[0], H[1], H[2], H[3]);
  }
}

DEV void lru_fix(const PV& p, int stream, int l, int item, int fr, int quad) {
  const int n = item & 7, gc = item >> 3;
  const int nck = stream ? 16 : 4;
  const int seq = stream ? (gc >> 4) : (gc >> 2), cidx = stream ? (gc & 15) : (gc & 3);
  const int ch0 = n * 64 + 4 * fr;
  const float* sm = (const float*)(p.WS() + W_MODP);
  float hf[4] = {0.f, 0.f, 0.f, 0.f}, hb[4] = {0.f, 0.f, 0.f, 0.f};
  if (stream) {
    const float4 f4 = *(const float4*)(p.IN(6) + ((size_t)(seq * 2 + l) * 2 + 0) * 512 + ch0);
    const float4 b4 = *(const float4*)(p.IN(6) + ((size_t)(seq * 2 + l) * 2 + 1) * 512 + ch0);
    hf[0] = f4.x; hf[1] = f4.y; hf[2] = f4.z; hf[3] = f4.w; hb[0] = b4.x; hb[1] = b4.y; hb[2] = b4.z; hb[3] = b4.w;
  }
  const int g0 = gc - cidx;
  for (int c = 0; c < cidx; ++c) {
    const float* s0 = sm + ((size_t)((g0 + c) * 8 + n) * 2 + 0) * 128 + 4 * fr;
    const float4 pa = *(const float4*)s0, lu = *(const float4*)(s0 + 64);
    hf[0] = pa.x * hf[0] + lu.x; hf[1] = pa.y * hf[1] + lu.y; hf[2] = pa.z * hf[2] + lu.z; hf[3] = pa.w * hf[3] + lu.w;
  }
  for (int c = nck - 1; c > cidx; --c) {
    const float* s1 = sm + ((size_t)((g0 + c) * 8 + n) * 2 + 1) * 128 + 4 * fr;
    const float4 pa = *(const float4*)s1, lu = *(const float4*)(s1 + 64);
    hb[0] = pa.x * hb[0] + lu.x; hb[1] = pa.y * hb[1] + lu.y; hb[2] = pa.z * hb[2] + lu.z; hb[3] = pa.w * hb[3] + lu.w;
  }
  if (!stream && quad == 0) {
    if (cidx == nck - 1) {
      const float* s0 = sm + ((size_t)(gc * 8 + n) * 2 + 0) * 128 + 4 * fr;
      const float4 pa = *(const float4*)s0, lu = *(const float4*)(s0 + 64);
      *(float4*)(p.OUT() + O_LRU + ((size_t)(seq * 2 + l) * 2 + 0) * 512 + ch0) = make_float4(pa.x * hf[0] + lu.x, pa.y * hf[1] + lu.y, pa.z * hf[2] + lu.z, pa.w * hf[3] + lu.w);
    }
    if (cidx == 0) {
      const float* s1 = sm + ((size_t)(gc * 8 + n) * 2 + 1) * 128 + 4 * fr;
      const float4 pa = *(const float4*)s1, lu = *(const float4*)(s1 + 64);
      *(float4*)(p.OUT() + O_LRU + ((size_t)(seq * 2 + l) * 2 + 1) * 512 + ch0) = make_float4(pa.x * hb[0] + lu.x, pa.y * hb[1] + lu.y, pa.z * hb[2] + lu.z, pa.w * hb[3] + lu.w);
    }
  }
  const bf16_t* P = (const bf16_t*)(p.WS() + W_P);
  bf16_t* LOC = (bf16_t*)(p.WS() + W_HF);
  const bf16_t* APR = (const bf16_t*)(p.WS() + W_H);
#pragma unroll 4
  for (int k = 0; k < 16; ++k) {
    const size_t tok = (size_t)gc * 64 + k * 4 + quad;
    const size_t e = tok * 512 + ch0;
    const uint2 lf = *(const uint2*)(LOC + e), lb = *(const uint2*)(LOC + (size_t)NTOK * 512 + e);
    const uint2 af = *(const uint2*)(APR + e), ab = *(const uint2*)(APR + (size_t)NTOK * 512 + e);
    const uint2 cg = *(const uint2*)(P + tok * NCOL + C_CG + ch0);
    float y[4];
#pragma unroll
    for (int q = 0; q < 4; ++q) {
      const unsigned wlf = (q < 2) ? lf.x : lf.y, wlb = (q < 2) ? lb.x : lb.y, waf = (q < 2) ? af.x : af.y, wab = (q < 2) ? ab.x : ab.y, wcg = (q < 2) ? cg.x : cg.y;
      const float vlf = (q & 1) ? __uint_as_float(wlf & 0xffff0000u) : __uint_as_float(wlf << 16);
      const float vlb = (q & 1) ? __uint_as_float(wlb & 0xffff0000u) : __uint_as_float(wlb << 16);
      const float vaf = (q & 1) ? __uint_as_float(waf & 0xffff0000u) : __uint_as_float(waf << 16);
      const float vab = (q & 1) ? __uint_as_float(wab & 0xffff0000u) : __uint_as_float(wab << 16);
      const float vcg = (q & 1) ? __uint_as_float(wcg & 0xffff0000u) : __uint_as_float(wcg << 16);
      y[q] = ((vlf + vaf * hf[q]) + (vlb + vab * hb[q])) * vcg;
    }
    store_bf16x4(LOC + e, y[0], y[1], y[2], y[3]);
  }
}

DEV void phase_lru(const PV& p, int stream, int l, unsigned char* smem) {
  const int tix = ltid(); const int lane = tix & 63, wv = tix >> 6, fr = lane & 15, quad = lane >> 4;
  unsigned char* wl = smem + AT_LRU + wv * 2048;
  for (int it = blockIdx.x * 8 + wv; it < 2048; it += gridDim.x * 8) lru_item(p, stream, l, it, wl, lane, fr, quad);
}

DEV void phase_mixers(const PV& p, int stream, int l, unsigned char* smem) {
  const int tix = ltid(); const int lane = tix & 63, wv = tix >> 6, fr = lane & 15, quad = lane >> 4;
  int* ctrs = (int*)(p.WS() + W_CTR);
  int* workctr = ctrs + (stream * 2 + l);
  volatile int* qw = (volatile int*)(smem + AT_MISC);
  const int n_fix = 128;
  const int total = n_fix + (stream ? (256 + 512) : 512);
  auto next = [&]() { __syncthreads(); if (tix == 0) *qw = atomicAdd(workctr, 1); __syncthreads(); int v = *qw; asm volatile("" : "+v"(v)); return v; };
  int it = next();
  while (it < n_fix) { lru_fix(p, stream, l, it * 8 + wv, fr, quad); it = next(); }
  if (!stream) {
    while (it < total) { attn_ctx_item(p, l, it - n_fix, smem, tix, wv, fr, quad); it = next(); }
  } else {
    while (it < n_fix + 256) { attn_latA_item(p, l, it - n_fix, smem, tix, wv, fr, quad); it = next(); }
    while (it < total) { attn_latB_item(p, l, it - n_fix - 256, smem, tix, wv, fr, quad); it = next(); }
  }
}

DEV void phase_merge(const PV& p, int l, unsigned char* smem) {
  const int tix = ltid(); const int lane = tix & 63, wv = tix >> 6, wr = wv >> 1, wc = wv & 1, fr = lane & 15, quad = lane >> 4;
  const bf16_t* P = (const bf16_t*)(p.WS() + W_P);
  bf16_t* Z = (bf16_t*)(p.WS() + W_HB);
  const bf16_t* YF = (const bf16_t*)(p.WS() + W_HF);
  for (int t = blockIdx.x; t < 256; t += gridDim.x) {
    const int xcd = t & 7, j = t >> 3, pm = xcd * 4 + (j & 3), pn = j >> 2;
    f32x4 z[4][4];
#pragma unroll
    for (int m = 0; m < 4; ++m)
#pragma unroll
      for (int n = 0; n < 4; ++n) z[m][n] = (f32x4){0.f, 0.f, 0.f, 0.f};
    f32x4 acc[4][4];
#pragma unroll 1
    for (int i = 0; i < 3; ++i) {
      const int br = i;
      const bf16_t* Ap; int lda;
      if (i < 2) { Ap = (const bf16_t*)(p.WS() + W_Y) + (size_t)pm * 256 * 1024 + i * 512; lda = 1024; }
      else { Ap = YF + (size_t)pm * 256 * 512; lda = 512; }
      const bf16_t* Wb = (const bf16_t*)(p.WS() + W_WT_BR) + ((size_t)(l * 3 + br) * 1024 + pn * 128) * 512;
#pragma unroll
      for (int m = 0; m < 4; ++m)
#pragma unroll
        for (int n = 0; n < 4; ++n) acc[m][n] = (f32x4){0.f, 0.f, 0.f, 0.f};
      gemm_kloop(Ap, lda, Wb, 512, 512, smem, acc, wr, wc, fr, quad, tix);
      {
        const bf16_t* G = P + (size_t)(pm * 256) * NCOL + C_MG + br * 1024 + pn * 128;
        const bf16_t* gp = G + (size_t)(tix >> 4) * NCOL + (((tix & 15) ^ ((tix >> 4) & 15)) * 8);
        unsigned char* lp = smem + tix * 16;
#pragma unroll
        for (int k = 0; k < 8; ++k) {
          __builtin_amdgcn_global_load_lds((const void*)gp, (LAS void*)lp, 16, 0, 0);
          gp += 32 * NCOL; lp += 8192;
        }
        asm volatile("s_waitcnt vmcnt(0)" ::: "memory");
        __syncthreads();
#pragma unroll
        for (int m = 0; m < 4; ++m)
#pragma unroll
          for (int n = 0; n < 4; ++n) {
            const int row = wr * 64 + m * 16 + fr, colb = (wc * 64 + n * 16 + 4 * quad) * 2;
            const bf16x4 g = *(const bf16x4*)(smem + row * 256 + (((colb >> 4) ^ (row & 15)) << 4) + (colb & 15));
#pragma unroll
            for (int e = 0; e < 4; ++e) z[m][n][e] += acc[m][n][e] * bf2f((unsigned short)g[e]);
          }
      }
    }
#pragma unroll
    for (int m = 0; m < 4; ++m)
#pragma unroll
      for (int n = 0; n < 4; ++n) {
        const int row = pm * 256 + wr * 64 + m * 16 + fr, col = pn * 128 + wc * 64 + n * 16 + 4 * quad;
        store_bf16x4(Z + (size_t)row * 1024 + col, z[m][n][0], z[m][n][1], z[m][n][2], z[m][n][3]);
      }
  }
}

DEV void phase_out(const PV& p, int stream, int l, unsigned char* smem) {
  const int tix = ltid(); const int lane = tix & 63, wv = tix >> 6, wr = wv >> 1, wc = wv & 1, fr = lane & 15, quad = lane >> 4;
  const bf16_t* Z = (const bf16_t*)(p.WS() + W_HB);
  const float* xin = (l == 0) ? p.IN(stream) : (p.OUT() + (size_t)stream * 8388608);
  float* yout = p.OUT() + (size_t)stream * 8388608;
  const float* mod = (const float*)(p.WS() + W_MOD);
  for (int t = blockIdx.x; t < 256; t += gridDim.x) {
    const int xcd = t & 7, j = t >> 3, pm = xcd * 4 + (j & 3), pn = j >> 2;
    f32x4 acc[4][4];
#pragma unroll
    for (int m = 0; m < 4; ++m)
#pragma unroll
      for (int n = 0; n < 4; ++n) acc[m][n] = (f32x4){0.f, 0.f, 0.f, 0.f};
    gemm_kloop(Z + (size_t)pm * 256 * 1024, 1024, (const bf16_t*)(p.WS() + W_WT_OUT) + ((size_t)l * 1024 + pn * 128) * 1024, 1024, 1024, smem, acc, wr, wc, fr, quad, tix);
#pragma unroll
    for (int m = 0; m < 4; ++m)
#pragma unroll
      for (int n = 0; n < 4; ++n) {
        const int row = pm * 256 + wr * 64 + m * 16 + fr, col = pn * 128 + wc * 64 + n * 16 + 4 * quad;
        const int jj = stream ? 1 + (row >> 10) : 0;
        const float4 gt = *(const float4*)(mod + (size_t)(l * 9 + jj) * 3072 + 2048 + col);
        const float4 xv = *(const float4*)(xin + (size_t)row * 1024 + col);
        *(float4*)(yout + (size_t)row * 1024 + col) = make_float4(xv.x + gt.x * acc[m][n][0], xv.y + gt.y * acc[m][n][1], xv.z + gt.z * acc[m][n][2], xv.w + gt.w * acc[m][n][3]);
      }
  }
}

__global__ void __launch_bounds__(512) mega(Params pp, int ph_lo, int ph_hi) {
  extern __shared__ __attribute__((aligned(16))) unsigned char smem[];
  cg::grid_group grid = cg::this_grid();
  volatile LAS unsigned* xst = (volatile LAS unsigned*)(smem + LDS_GEMM);
  if (threadIdx.x == 0) { xst[0] = 0u; xst[1] = 0u; xst[2] = 0u; xst[3] = 0u; }
  __syncthreads();
  XcdBarrier xb = xcd_barrier_post((unsigned*)(pp.ws + W_BAR), xst);
  for (int ph = ph_lo; ph <= ph_hi; ++ph) {
    if (ph == 2 + 2 * 6) continue;
    if (ph > ph_lo) { if (ph_hi < 0) grid.sync(); xcd_barrier(xb); }
    PV p; p.pp = &pp;
    asm volatile("s_mov_b64 %0, 0" : "=s"(p.zs));
    {
      __attribute__((address_space(1))) unsigned char* gws = (__attribute__((address_space(1))) unsigned char*)pp.ws;
      __attribute__((address_space(1))) float* gout = (__attribute__((address_space(1))) float*)pp.out;
      asm volatile("" : "+s"(gws), "+s"(gout));
      p.ws = (unsigned char*)gws; p.out = (float*)gout;
    }
#ifndef PHM
#define PHM 127
#endif
    if (ph == 0) { if (PHM & 1) phase_prep(p, smem);
#ifdef DUP_PREP
      grid.sync(); phase_prep(p, smem);
#endif
    }
    else if (ph == 1) { if (PHM & 1) phase_modfin(p); }
    else {
      const int si = (ph - 2) / 6, sub = (ph - 2) % 6, stream = si >> 1, l = si & 1;
      if (sub == 0) phase_norm(p, stream, l);
      else if (sub == 1) phase_inproj(p, stream, l, smem);
      else if (sub == 2) phase_lru(p, stream, l, smem);
      else if (sub == 3) phase_mixers(p, stream, l, smem);
      else if (sub == 4) phase_merge(p, l, smem);
      else { phase_out(p, stream, l, smem); if (si == 1) phase_norm(p, 1, 0); }
    }
  }
}

extern "C" void kernel_launch(void* const* d_in, const int* in_sizes, int n_in, void* d_out, int out_size, void* d_ws, size_t ws_size, hipStream_t stream) {
  Params p{};
  for (int i = 0; i < 28; ++i) p.in[i] = (const float*)d_in[i];
  p.out = (float*)d_out;
  p.ws = (unsigned char*)d_ws;
  static int grid_blocks = 0;
  if (!grid_blocks) {
    hipFuncSetAttribute((const void*)mega, hipFuncAttributeMaxDynamicSharedMemorySize, LDS_BYTES);
    int dev = 0, cus = 0, per_cu = 0;
    hipGetDevice(&dev);
    hipDeviceGetAttribute(&cus, hipDeviceAttributeMultiprocessorCount, dev);
    hipOccupancyMaxActiveBlocksPerMultiprocessor(&per_cu, mega, 512, LDS_BYTES);
    if (per_cu < 1) per_cu = 1;
    grid_blocks = cus;
    if (ws_size < W_END) fprintf(stderr, "workspace too small: %zu < %zu\n", ws_size, (size_t)W_END);
  }
  hipMemsetAsync((unsigned char*)d_ws + W_BAR, 0, XCD_BAR_WORDS * 4, stream);
#if ONE_LAUNCH
  int lo = 0, hi = NPHASE - 1;
  void* args[] = {&p, &lo, &hi};
  hipError_t e = hipLaunchCooperativeKernel((const void*)mega, dim3(grid_blocks), dim3(512), args, LDS_BYTES, stream);
  if (e != hipSuccess) fprintf(stderr, "cooperative launch failed: %s (grid %d)\n", hipGetErrorString(e), grid_blocks);
#else
  for (int ph = 0; ph < NPHASE; ++ph) hipLaunchKernelGGL(mega, dim3(grid_blocks), dim3(512), LDS_BYTES, stream, p, ph, ph);
#endif
}
```
